# Optimizing an MI355X kernel written in HIP

```python
import jax, jax.numpy as jnp
from jax import lax
import numpy as np

D_MODEL = 1024
BATCH = 8
SEQ = 2048
DEPTH = 4

CHUNK = 64
N_MEM = 256
N_A_LAYERS = DEPTH // 2
N_B_LAYERS = DEPTH - N_A_LAYERS
MAIN_WIDTH = 3 * D_MODEL // 4
MEM_WIDTH = D_MODEL // 4
MIX_WIDTH = MAIN_WIDTH + MEM_WIDTH
HG_HEAD_DIM = 128
HG_HEADS = MAIN_WIDTH // HG_HEAD_DIM
FOX_HEAD_DIM = 64
FOX_HEADS = MAIN_WIDTH // FOX_HEAD_DIM
MEM_HEADS = 4
MEM_HEAD_DIM = MEM_WIDTH // MEM_HEADS
D_FF = 2816
Q_BLOCK = 128
EPS = 1e-6
A_IN_WIDTH = 4 * MAIN_WIDTH + MEM_WIDTH
B_IN_WIDTH = 2 * MAIN_WIDTH + MEM_WIDTH
KV_WIDTH = 2 * MAIN_WIDTH + FOX_HEADS

kernel_name = 'hybrid_hgrn2_fox_yoco_macaron'


def rms_norm(x, gain):
    x32 = x.astype(jnp.float32)
    y = x32 * lax.rsqrt(jnp.mean(x32 * x32, axis=-1, keepdims=True) + EPS)
    return (y * gain.astype(jnp.float32)).astype(x.dtype)


def swiglu(h, w_gate, w_up, w_down):
    return (jax.nn.silu(h @ w_gate) * (h @ w_up)) @ w_down


def split_heads(t, n_heads):
    b, s, _ = t.shape
    return t.reshape(b, s, n_heads, -1).transpose(0, 2, 1, 3)


def merge_heads(t):
    b, h, s, d = t.shape
    return t.transpose(0, 2, 1, 3).reshape(b, s, h * d)


def hgrn2_recurrence(q, k, v, log_f):
    b, h, s, dk = q.shape
    dv = v.shape[-1]
    n = s // CHUNK

    def to_chunks(t):
        return t.reshape(b, h, n, CHUNK, t.shape[-1]).transpose(2, 0, 1, 3, 4)

    qc, kc, vc = to_chunks(q), to_chunks(k), to_chunks(v)
    cum = jnp.cumsum(to_chunks(log_f), axis=-2)
    tri = jnp.tril(jnp.ones((CHUNK, CHUNK), dtype=bool))

    def step(state, inp):
        q_, k_, v_, c_ = inp
        diff = c_[:, :, :, None, :] - c_[:, :, None, :, :]
        decay = jnp.exp(jnp.where(tri[:, :, None], diff, -jnp.inf))
        scores = jnp.einsum('bhtd,bhsd,bhtsd->bhts', q_, k_, decay)
        o = (jnp.einsum('bhts,bhsv->bhtv', scores, v_)
             + jnp.einsum('bhtd,bhdv->bhtv', q_ * jnp.exp(c_), state))
        c_end = c_[:, :, -1, :]
        state = (jnp.exp(c_end)[..., None] * state
                 + jnp.einsum('bhsd,bhsv->bhdv', k_ * jnp.exp(c_end[:, :, None, :] - c_), v_))
        return state, o

    state0 = jnp.zeros((b, h, dk, dv), jnp.float32)
    _, o = lax.scan(step, state0, (qc, kc, vc, cum))
    return o.transpose(1, 2, 0, 3, 4).reshape(b, h, s, dv)


def forgetting_attention(q, k, v, cum_log_f):
    s = q.shape[2]
    scale = FOX_HEAD_DIM ** -0.5
    outs = []
    for blk in range(s // Q_BLOCK):
        start = blk * Q_BLOCK
        end = start + Q_BLOCK
        logits = jnp.einsum('bhqd,bhkd->bhqk', q[:, :, start:end], k[:, :, :end]).astype(jnp.float32) * scale
        logits = logits + cum_log_f[:, :, start:end, None] - cum_log_f[:, :, None, :end]
        causal = jnp.arange(end)[None, :] <= jnp.arange(start, end)[:, None]
        p = jax.nn.softmax(jnp.where(causal, logits, -jnp.inf), axis=-1)
        outs.append(jnp.einsum('bhqk,bhkd->bhqd', p.astype(v.dtype), v[:, :, :end]))
    return jnp.concatenate(outs, axis=2)


def memory_attention(qm_raw, mem_n, w_mem_kv, q_gain, k_gain):
    kv = mem_n @ w_mem_kv
    km = rms_norm(split_heads(kv[..., :MEM_WIDTH], MEM_HEADS), k_gain)
    vm = split_heads(kv[..., MEM_WIDTH:], MEM_HEADS)
    qm = rms_norm(split_heads(qm_raw, MEM_HEADS), q_gain)
    logits = jnp.einsum('bhqd,bhkd->bhqk', qm, km).astype(jnp.float32) * (MEM_HEAD_DIM ** -0.5)
    p = jax.nn.softmax(logits, axis=-1)
    return merge_heads(jnp.einsum('bhqk,bhkd->bhqd', p.astype(vm.dtype), vm))


def setup_inputs(seed: int = 0) -> dict:
    key = jax.random.key(seed)
    ks = jax.random.split(key, 32)

    def w(k, shape, fan_in):
        return jax.random.normal(k, shape, jnp.float32) * (fan_in ** -0.5)

    def g(k, shape):
        return 1.0 + 0.02 * jax.random.normal(k, shape, jnp.float32)

    return {
        'x': jax.random.normal(ks[0], (BATCH, SEQ, D_MODEL), jnp.float32),
        'mem': jax.random.normal(ks[1], (BATCH, N_MEM, D_MODEL), jnp.float32),
        'ffn1_norm': g(ks[2], (DEPTH, D_MODEL)),
        'ffn1_w_gate': w(ks[3], (DEPTH, D_MODEL, D_FF), D_MODEL),
        'ffn1_w_up': w(ks[4], (DEPTH, D_MODEL, D_FF), D_MODEL),
        'ffn1_w_down': w(ks[5], (DEPTH, D_FF, D_MODEL), D_FF),
        'mix_norm': g(ks[6], (DEPTH, D_MODEL)),
        'mem_norm': g(ks[7], (DEPTH, D_MODEL)),
        'w_mem_kv': w(ks[8], (DEPTH, D_MODEL, 2 * MEM_WIDTH), D_MODEL),
        'mem_q_gain': g(ks[9], (DEPTH, MEM_HEAD_DIM)),
        'mem_k_gain': g(ks[10], (DEPTH, MEM_HEAD_DIM)),
        'w_in_a': w(ks[11], (N_A_LAYERS, D_MODEL, A_IN_WIDTH), D_MODEL),
        'hgrn_lb_logits': jax.random.normal(ks[12], (N_A_LAYERS, MAIN_WIDTH), jnp.float32),
        'hgrn_o_gain': g(ks[13], (N_A_LAYERS, HG_HEAD_DIM)),
        'w_in_b': w(ks[14], (N_B_LAYERS, D_MODEL, B_IN_WIDTH), D_MODEL),
        'fox_q_gain': g(ks[15], (N_B_LAYERS, FOX_HEAD_DIM)),
        'kv_norm': g(ks[16], (D_MODEL,)),
        'w_kv': w(ks[17], (D_MODEL, KV_WIDTH), D_MODEL),
        'fox_f_bias': 0.1 * jax.random.normal(ks[18], (FOX_HEADS,), jnp.float32),
        'fox_k_gain': g(ks[19], (FOX_HEAD_DIM,)),
        'w_out': w(ks[20], (DEPTH, MIX_WIDTH, D_MODEL), MIX_WIDTH),
        'ffn2_norm': g(ks[21], (DEPTH, D_MODEL)),
        'ffn2_w_gate': w(ks[22], (DEPTH, D_MODEL, D_FF), D_MODEL),
        'ffn2_w_up': w(ks[23], (DEPTH, D_MODEL, D_FF), D_MODEL),
        'ffn2_w_down': w(ks[24], (DEPTH, D_FF, D_MODEL), D_FF),
    }


def reference(x, mem, ffn1_norm, ffn1_w_gate, ffn1_w_up, ffn1_w_down, mix_norm, mem_norm,
              w_mem_kv, mem_q_gain, mem_k_gain, w_in_a, hgrn_lb_logits, hgrn_o_gain,
              w_in_b, fox_q_gain, kv_norm, w_kv, fox_f_bias, fox_k_gain, w_out,
              ffn2_norm, ffn2_w_gate, ffn2_w_up, ffn2_w_down):
    lb = jnp.cumsum(jax.nn.softmax(hgrn_lb_logits.astype(jnp.float32), axis=0), axis=0)
    lb = lb - lb[0:1]
    k_sh = v_sh = cum_log_f = None
    for l in range(DEPTH):
        x = x + 0.5 * swiglu(rms_norm(x, ffn1_norm[l]), ffn1_w_gate[l], ffn1_w_up[l], ffn1_w_down[l])
        h = rms_norm(x, mix_norm[l])
        mem_n = rms_norm(mem, mem_norm[l])
        if l < N_A_LAYERS:
            proj = h @ w_in_a[l]
            q_raw = proj[..., :MAIN_WIDTH]
            f_raw = proj[..., MAIN_WIDTH:2 * MAIN_WIDTH]
            i_raw = proj[..., 2 * MAIN_WIDTH:3 * MAIN_WIDTH]
            g_raw = proj[..., 3 * MAIN_WIDTH:4 * MAIN_WIDTH]
            qm_raw = proj[..., 4 * MAIN_WIDTH:]
            f = lb[l] + (1.0 - lb[l]) * jax.nn.sigmoid(f_raw.astype(jnp.float32))
            q = jax.nn.silu(q_raw.astype(jnp.float32))
            o = hgrn2_recurrence(split_heads(q, HG_HEADS), split_heads(1.0 - f, HG_HEADS),
                                 split_heads(i_raw.astype(jnp.float32), HG_HEADS),
                                 split_heads(jnp.log(f), HG_HEADS))
            main = merge_heads(rms_norm(o, hgrn_o_gain[l])) * jax.nn.silu(g_raw.astype(jnp.float32))
        else:
            j = l - N_A_LAYERS
            proj = h @ w_in_b[j]
            q = rms_norm(split_heads(proj[..., :MAIN_WIDTH], FOX_HEADS), fox_q_gain[j])
            gate = proj[..., MAIN_WIDTH:2 * MAIN_WIDTH]
            qm_raw = proj[..., 2 * MAIN_WIDTH:]
            o = forgetting_attention(q, k_sh, v_sh, cum_log_f)
            main = merge_heads(o) * jax.nn.sigmoid(gate)
        mem_o = memory_attention(qm_raw, mem_n, w_mem_kv[l], mem_q_gain[l], mem_k_gain[l])
        mixed = jnp.concatenate([main.astype(x.dtype), mem_o.astype(x.dtype)], axis=-1)
        x = x + mixed @ w_out[l]
        x = x + 0.5 * swiglu(rms_norm(x, ffn2_norm[l]), ffn2_w_gate[l], ffn2_w_up[l], ffn2_w_down[l])
        if l == N_A_LAYERS - 1:
            kvf = rms_norm(x, kv_norm) @ w_kv
            k_sh = rms_norm(split_heads(kvf[..., :MAIN_WIDTH], FOX_HEADS), fox_k_gain)
            v_sh = split_heads(kvf[..., MAIN_WIDTH:2 * MAIN_WIDTH], FOX_HEADS)
            log_f = jax.nn.log_sigmoid(kvf[..., 2 * MAIN_WIDTH:].astype(jnp.float32) + fox_f_bias.astype(jnp.float32))
            cum_log_f = jnp.cumsum(log_f.transpose(0, 2, 1), axis=-1)
    return x
```

```cpp
#include <hip/hip_runtime.h>
#include <hip/hip_cooperative_groups.h>
#include <cstdio>
#include <cstdint>
namespace cg = cooperative_groups;
namespace pg8 {
#define PG8_LAS __attribute__((address_space(3)))
typedef unsigned short bf16_t;
typedef short bf16x8 __attribute__((ext_vector_type(8)));
typedef float f32x4 __attribute__((ext_vector_type(4)));
typedef unsigned u32x4 __attribute__((ext_vector_type(4)));
constexpr int BM = 256, BK = 64, HALF = 128, HTB = HALF * BK * 2  , STAGE_BYTES = 8 * HTB, NXCD = 8, WGM = 4;

__host__ __device__ __forceinline__ int lds_byte(int r, int c) { const int st = (r >> 4) * 2 + (c >> 5), rr = r & 15, cc = c & 31, ob = rr * 64 + cc * 2; return st * 1024 + (ob ^ (((ob >> 9) & 1) << 5)); }
__host__ __device__ __forceinline__ void stage_rc(int b, int& R, int& C) { const int st = b / 1024, sb = b % 1024, swz = sb ^ (((sb >> 9) & 1) << 5); R = (st >> 1) * 16 + swz / 64; C = (st & 1) * 32 + (swz % 64) / 2; }
__host__ __device__ __forceinline__ int perm32(int rho) { const int n = rho >> 4, i = rho & 15; return 8 * (i >> 2) + 4 * n + (i & 3); }

struct Unit { int pm, pn; };
struct Gemm { const bf16_t* A; const bf16_t* Bt; int M, N, K; };

struct StaticOrder {
    int nM, nN, nwg, G, c;
    __host__ __device__ void init(int M, int N, int G_, int c_) { nM = M / BM; nN = N / BM; nwg = nM * nN; G = G_; c = c_; }
    __host__ __device__ bool next(int i, Unit& u) const {
        const long L = (long)i * G + c; if (L >= nwg) return false;
        int wgid = (int)L; { const int q = nwg / NXCD, r = nwg % NXCD, xcd = wgid % NXCD, off = wgid / NXCD; wgid = (xcd < r ? xcd * (q + 1) : r * (q + 1) + (xcd - r) * q) + off; }
        const int nig = WGM * nN, gid = wgid / nig, fm = gid * WGM, gsz = (nM - fm) < WGM ? (nM - fm) : WGM;
        u.pm = fm + ((wgid % nig) % gsz); u.pn = (wgid % nig) / gsz; return true;
    }
    __device__ __forceinline__ void a_ready(const Unit&) const {}
    __device__ __forceinline__ void done(const Unit&) const {}
};

template <class Epi, class Sched, bool ALIGN_EPI = false, bool SP2 = false>
__device__ __forceinline__ void gemm_phase(PG8_LAS unsigned char* lds, const Gemm g, const Sched& S, const Epi& E) {
    int tid = threadIdx.x; asm volatile("" : "+v"(tid)); const int wid = __builtin_amdgcn_readfirstlane(tid >> 6), lane = tid & 63, wr = wid >> 2, wc = wid & 3, fr = lane & 15, fq = lane >> 4;
    const int K = g.K, nt = K / BK;
    unsigned voffA[2], voffB[2];
#pragma unroll
    for (int i = 0; i < 2; ++i) { int R, C; stage_rc(tid * 16 + i * 8192, R, C); const int Rb = Epi::PERM ? ((R & ~31) + perm32(R & 31)) : R;
        voffA[i] = (unsigned)(R * K + C) * 2u; voffB[i] = (unsigned)(Rb * K + C) * 2u; }
    const size_t kstep = (size_t)(BK * 2);
    const size_t hstep = (size_t)HALF * K * 2;
    const size_t tstep = 2 * hstep;
    const unsigned ldsw = (unsigned)wid * 1024u;
    const int aoff = lds_byte(wr * 64 + fr, fq * 8), boff = lds_byte(wc * 32 + fr, fq * 8);
#define PG8_SA(b, h) (((b) * 2 + (h)) * HTB)
#define PG8_SB(b, h) ((4 + (b) * 2 + (h)) * HTB)
#define PG8_STAGE(bufoff, gbase, voff) do { _Pragma("unroll") for (int _i = 0; _i < 2; ++_i) \
        __builtin_amdgcn_global_load_lds((const unsigned*)((const char*)(gbase) + (voff)[_i]), (PG8_LAS unsigned*)(lds + (bufoff) + ldsw + _i * 8192), 16, 0, 0); } while (0)
#define PG8_LDA(dst, b, h) do { _Pragma("unroll") for (int m = 0; m < 4; ++m) _Pragma("unroll") for (int k = 0; k < 2; ++k) dst[m][k] = *(const PG8_LAS bf16x8*)(lds + PG8_SA(b, h) + aoff + m * 2048 + k * 1024); } while (0)
#define PG8_LDB(dst, b, h) do { _Pragma("unroll") for (int n = 0; n < 2; ++n) _Pragma("unroll") for (int k = 0; k < 2; ++k) dst[n][k] = *(const PG8_LAS bf16x8*)(lds + PG8_SB(b, h) + boff + n * 2048 + k * 1024); } while (0)
#define PG8_MMA(ai, bj, At, Bt) do { __builtin_amdgcn_s_setprio(1); _Pragma("unroll") for (int m = 0; m < 4; ++m) _Pragma("unroll") for (int n = 0; n < 2; ++n) _Pragma("unroll") for (int k = 0; k < 2; ++k) \
        acc[ai][bj][m][n] = __builtin_amdgcn_mfma_f32_16x16x32_bf16(Bt[n][k], At[m][k], acc[ai][bj][m][n], 0, 0, 0); __builtin_amdgcn_s_setprio(0); } while (0)
#define PG8_WAIT_V(n) asm volatile("s_waitcnt vmcnt(" #n ")" ::: "memory")
#define PG8_WAIT_L(n) asm volatile("s_waitcnt lgkmcnt(" #n ")" ::: "memory")
#define PG8_BAR __builtin_amdgcn_s_barrier()
#define PG8_SCHED __builtin_amdgcn_sched_barrier(0)
    Unit cur, nxt; int ui = 0;
    if (!S.next(0, cur)) return;
    f32x4 acc[2][2][4][2];
#pragma unroll
    for (int a = 0; a < 2; ++a)
#pragma unroll
        for (int b = 0; b < 2; ++b)
#pragma unroll
            for (int m = 0; m < 4; ++m)
#pragma unroll
                for (int n = 0; n < 2; ++n) acc[a][b][m][n] = (f32x4){0.f, 0.f, 0.f, 0.f};
    bf16x8 At[4][2], B0[2][2], B1[2][2];
    const char* cA = (const char*)g.A + (size_t)cur.pm * tstep; const char* cB = (const char*)g.Bt + (size_t)cur.pn * tstep;
    S.a_ready(cur);
    if constexpr (SP2) {
        PG8_STAGE(PG8_SB(0, 0), cB, voffB); PG8_STAGE(PG8_SB(0, 1), cB + hstep, voffB); PG8_STAGE(PG8_SA(0, 0), cA, voffA); PG8_STAGE(PG8_SA(0, 1), cA + hstep, voffA);
        if (wr == 1) PG8_BAR;
        PG8_WAIT_V(2); PG8_BAR;
        PG8_STAGE(PG8_SB(1, 0), cB + kstep, voffB); PG8_STAGE(PG8_SA(1, 0), cA + kstep, voffA); PG8_STAGE(PG8_SB(1, 1), cB + hstep + kstep, voffB);
        PG8_WAIT_V(6); PG8_BAR;
    } else {
        PG8_STAGE(PG8_SB(0, 0), cB, voffB); PG8_STAGE(PG8_SA(0, 0), cA, voffA); PG8_STAGE(PG8_SB(0, 1), cB + hstep, voffB); PG8_STAGE(PG8_SA(0, 1), cA + hstep, voffA);
        if (wr == 1) PG8_BAR;
        PG8_WAIT_V(4); PG8_BAR;
        PG8_STAGE(PG8_SB(1, 0), cB + kstep, voffB); PG8_STAGE(PG8_SA(1, 0), cA + kstep, voffA); PG8_STAGE(PG8_SB(1, 1), cB + hstep + kstep, voffB);
        PG8_WAIT_V(6); PG8_BAR;
    }
    for (;;) {
        const bool has_next = S.next(ui + 1, nxt);
        const char* nA = has_next ? (const char*)g.A + (size_t)nxt.pm * tstep : cA; const char* nB = has_next ? (const char*)g.Bt + (size_t)nxt.pn * tstep : cB;
        for (int t = 0; t < nt; t += 2) {
            const bool last = (t == nt - 2);
            const char* a1 = cA + (size_t)(t + 1) * kstep;
            const char* a2 = last ? nA : cA + (size_t)(t + 2) * kstep; const char* b2 = last ? nB : cB + (size_t)(t + 2) * kstep;
            const char* a3 = a2 + kstep; const char* b3 = b2 + kstep;
            if (last && has_next) S.a_ready(nxt);
            if constexpr (SP2) {
            PG8_LDB(B0, 0, 0); PG8_LDB(B1, 0, 1); PG8_SCHED; PG8_LDA(At, 0, 0); PG8_STAGE(PG8_SA(1, 1), a1 + hstep, voffA);
            PG8_WAIT_V(8); PG8_WAIT_L(0); PG8_BAR; PG8_MMA(0, 0, At, B0); PG8_MMA(0, 1, At, B1); PG8_BAR; PG8_SCHED;
            PG8_LDA(At, 0, 1); PG8_STAGE(PG8_SB(0, 0), b2, voffB); PG8_STAGE(PG8_SB(0, 1), b2 + hstep, voffB); PG8_STAGE(PG8_SA(0, 0), a2, voffA);
            PG8_WAIT_V(8); PG8_WAIT_L(0); PG8_BAR; PG8_MMA(1, 0, At, B0); PG8_MMA(1, 1, At, B1); PG8_BAR; PG8_SCHED;
            PG8_LDB(B0, 1, 0); PG8_LDB(B1, 1, 1); PG8_SCHED; PG8_LDA(At, 1, 0); PG8_STAGE(PG8_SA(0, 1), a2 + hstep, voffA);
            PG8_WAIT_V(8); PG8_WAIT_L(0); PG8_BAR; PG8_MMA(0, 0, At, B0); PG8_MMA(0, 1, At, B1); PG8_BAR; PG8_SCHED;
            PG8_LDA(At, 1, 1); PG8_STAGE(PG8_SB(1, 0), b3, voffB); PG8_STAGE(PG8_SB(1, 1), b3 + hstep, voffB); PG8_STAGE(PG8_SA(1, 0), a3, voffA);
            PG8_WAIT_V(8); PG8_WAIT_L(0); PG8_BAR; PG8_MMA(1, 0, At, B0); PG8_MMA(1, 1, At, B1); PG8_BAR; PG8_SCHED;
            } else {
            PG8_LDB(B0, 0, 0); PG8_SCHED; PG8_LDA(At, 0, 0); PG8_STAGE(PG8_SA(1, 1), a1 + hstep, voffA);
            PG8_WAIT_L(8); PG8_BAR; PG8_WAIT_L(0); PG8_MMA(0, 0, At, B0); PG8_BAR; PG8_SCHED;
            PG8_LDB(B1, 0, 1); PG8_STAGE(PG8_SB(0, 0), b2, voffB);
            PG8_BAR; PG8_WAIT_L(0); PG8_MMA(0, 1, At, B1); PG8_BAR;
            PG8_LDA(At, 0, 1); PG8_STAGE(PG8_SA(0, 0), a2, voffA);
            PG8_BAR; PG8_WAIT_L(0); PG8_MMA(1, 0, At, B0); PG8_BAR; PG8_SCHED;
            PG8_STAGE(PG8_SB(0, 1), b2 + hstep, voffB);
            PG8_WAIT_V(6); PG8_BAR; PG8_MMA(1, 1, At, B1); PG8_BAR;
            PG8_LDB(B0, 1, 0); PG8_SCHED; PG8_LDA(At, 1, 0); PG8_STAGE(PG8_SA(0, 1), a2 + hstep, voffA);
            PG8_WAIT_L(8); PG8_BAR; PG8_WAIT_L(0); PG8_MMA(0, 0, At, B0); PG8_BAR; PG8_SCHED;
            PG8_LDB(B1, 1, 1); PG8_STAGE(PG8_SB(1, 0), b3, voffB);
            PG8_BAR; PG8_WAIT_L(0); PG8_MMA(0, 1, At, B1); PG8_BAR;
            PG8_LDA(At, 1, 1); PG8_STAGE(PG8_SA(1, 0), a3, voffA);
            PG8_BAR; PG8_WAIT_L(0); PG8_MMA(1, 0, At, B0); PG8_BAR; PG8_SCHED;
            PG8_STAGE(PG8_SB(1, 1), b3 + hstep, voffB);
            PG8_WAIT_V(6); PG8_BAR; PG8_MMA(1, 1, At, B1); PG8_BAR;
            }
        }
        if constexpr (ALIGN_EPI) { if (wr == 0) PG8_BAR; }
        if constexpr (!Epi::AFTER_DRAIN) { E(acc, cur, wr, wc, fr, fq); S.done(cur); }
        if (!has_next) break;
#pragma unroll
        for (int a = 0; a < 2; ++a)
#pragma unroll
            for (int b = 0; b < 2; ++b)
#pragma unroll
                for (int m = 0; m < 4; ++m)
#pragma unroll
                    for (int n = 0; n < 2; ++n) acc[a][b][m][n] = (f32x4){0.f, 0.f, 0.f, 0.f};
        cur = nxt; cA = nA; cB = nB; ++ui;
        if constexpr (ALIGN_EPI) { if (wr == 1) PG8_BAR; }
    }
    PG8_WAIT_V(0);
    if constexpr (!ALIGN_EPI) { if (wr == 0) PG8_BAR; }
    PG8_BAR;
    if constexpr (Epi::AFTER_DRAIN) { E.fused(acc, cur, wr, wc, fr, fq, lds, wid, lane); S.done(cur); }
#undef PG8_SA
#undef PG8_SB
#undef PG8_STAGE
#undef PG8_LDA
#undef PG8_LDB
#undef PG8_MMA
#undef PG8_WAIT_V
#undef PG8_WAIT_L
#undef PG8_BAR
#undef PG8_SCHED
}
}

#define DI __device__ __forceinline__
#define LAS __attribute__((address_space(3)))
using pg8::bf16_t; using pg8::bf16x8; using pg8::f32x4; using pg8::u32x4; using pg8::Unit;
typedef unsigned u32x2 __attribute__((ext_vector_type(2)));
typedef float f32x2 __attribute__((ext_vector_type(2)));
typedef __bf16 bf16x2_t __attribute__((ext_vector_type(2)));

constexpr int DM = 1024, BATCH = 8, SEQ = 2048, MTOK = BATCH * SEQ, NMEMT = 256, MMEM = BATCH * NMEMT;
constexpr int DFF = 2816, NGU = 2 * DFF, NINA = 3328, NINB = 1792, NKV = 1792, KVSRC = 1548, NMKV = 2048;
constexpr float EPS = 1e-6f, LOG2E = 1.4426950408889634f, QSCALE = 0.125f * 1.4426950408889634f;
constexpr int NTHREADS = 512, LDS_BYTES = 147456, XCD_BAR_WORDS_C = 3456, LDS_BARST = LDS_BYTES - 64;

constexpr size_t SZ_WGU = (size_t)NGU * DM * 2, SZ_WD = (size_t)DM * DFF * 2, SZ_WINA = (size_t)NINA * DM * 2, SZ_WINB = (size_t)NINB * DM * 2,
                 SZ_WKV = (size_t)NKV * DM * 2, SZ_WOUT = (size_t)DM * DM * 2, SZ_WMKV = (size_t)NMKV * DM * 2;
constexpr size_t O_WGU1 = 0, O_WD1 = O_WGU1 + 4 * SZ_WGU, O_WGU2 = O_WD1 + 4 * SZ_WD, O_WD2 = O_WGU2 + 4 * SZ_WGU, O_WINA = O_WD2 + 4 * SZ_WD,
                 O_WINB = O_WINA + 2 * SZ_WINA, O_WKV = O_WINB + 2 * SZ_WINB, O_WOUT = O_WKV + SZ_WKV, O_WMKV = O_WOUT + 4 * SZ_WOUT,
                 O_XB = O_WMKV + SZ_WMKV, O_U = O_XB + (size_t)MTOK * DM * 2;
constexpr size_t O_ACT = O_U, O_QB = O_U, O_LF = O_QB + (size_t)MTOK * 768 * 2, O_VB = O_LF + (size_t)MTOK * 768 * 4, O_MIX = O_VB + (size_t)MTOK * 768 * 2;
constexpr size_t SZ_U = (size_t)MTOK * 768 * 8 + (size_t)MTOK * 1024 * 2;
static_assert(SZ_U >= (size_t)MTOK * DFF * 2, "U region holds ACT");
constexpr size_t O_KSH = O_U + SZ_U, O_VSH = O_KSH + (size_t)MTOK * 768 * 2, O_LFX = O_VSH + (size_t)MTOK * 768 * 2, O_DL = O_LFX + 96 * 2048 * 4,
                 O_MEMB = O_DL + 96 * 2048 * 4, O_MK = O_MEMB + (size_t)MMEM * DM * 2, O_MV = O_MK + 4 * (size_t)MMEM * 256 * 2,
                 O_SSQ = O_MV + 4 * (size_t)MMEM * 256 * 2, O_SSQM = O_SSQ + 16 * (size_t)MTOK * 4, O_LBV = O_SSQM + (size_t)MMEM * 4, O_BAR = O_LBV + 2 * 768 * 4, WS_END = O_BAR + XCD_BAR_WORDS_C * 4;

struct Params { const float* in[25]; float* out; unsigned char* ws; };

DI unsigned pk2(float lo, float hi) { f32x2 v = {lo, hi}; bf16x2_t b = __builtin_convertvector(v, bf16x2_t); return __builtin_bit_cast(unsigned, b); }
DI float bflo(unsigned u) { return __uint_as_float(u << 16); }
DI float bfhi(unsigned u) { return __uint_as_float(u & 0xffff0000u); }
DI float bf1(bf16_t h) { return __uint_as_float((unsigned)h << 16); }
DI u32x4 pack8(f32x4 a, f32x4 b) { u32x4 w; w.x = pk2(a[0], a[1]); w.y = pk2(a[2], a[3]); w.z = pk2(b[0], b[1]); w.w = pk2(b[2], b[3]); return w; }
DI float silu_f(float x) { return x * __builtin_amdgcn_rcpf(1.f + __expf(-x)); }
DI float sigm_f(float x) { return __builtin_amdgcn_rcpf(1.f + __expf(-x)); }
DI float logsig_f(float z) { return fminf(z, 0.f) - __logf(1.f + __expf(-fabsf(z))); }
DI float wave_sum(float v) {
#pragma unroll
    for (int o = 1; o < 64; o <<= 1) v += __shfl_xor(v, o);
    return v;
}
DI float row_rstd(const float* ssq, int row, int fq) {
    const f32x4 a = *(const f32x4*)(ssq + (size_t)row * 16 + 4 * fq); float t = (a[0] + a[1]) + (a[2] + a[3]);
    t += __shfl_xor(t, 16); t += __shfl_xor(t, 32); return rsqrtf(t * (1.f / DM) + EPS); }
#define MFMA16(a, b, c) __builtin_amdgcn_mfma_f32_16x16x32_bf16((a), (b), (c), 0, 0, 0)

#define EPI_ROW_RSTD(ssq_) float rs[2][4]; \
    _Pragma("unroll") for (int ai = 0; ai < 2; ++ai) _Pragma("unroll") for (int m = 0; m < 4; ++m) rs[ai][m] = row_rstd(ssq_, row0 + ai * 128 + m * 16, fq);
struct EpiGateUp {
    static constexpr bool PERM = true, AFTER_DRAIN = false;
    bf16_t* O; const float* ssq;
    DI void operator()(f32x4 (&acc)[2][2][4][2], const Unit& u, int wr, int wc, int fr, int fq) const {
        const int row0 = u.pm * 256 + wr * 64 + fr, col0 = u.pn * 128 + wc * 32 + 8 * fq;
        EPI_ROW_RSTD(ssq)
#pragma unroll
        for (int ai = 0; ai < 2; ++ai)
#pragma unroll
            for (int m = 0; m < 4; ++m) {
                const int row = row0 + ai * 128 + m * 16; const float r1 = rs[ai][m];
                f32x4 o[2];
#pragma unroll
                for (int n = 0; n < 2; ++n) {
                    const f32x4 g = acc[ai][0][m][n] * r1, v = acc[ai][1][m][n] * r1;
#pragma unroll
                    for (int e = 0; e < 4; ++e) o[n][e] = silu_f(g[e]) * v[e];
                }
                *(u32x4*)(O + (size_t)row * DFF + col0) = pack8(o[0], o[1]);
            }
    }
};
struct EpiResid {
    static constexpr bool PERM = true, AFTER_DRAIN = false;
    const float* xin32; bf16_t* xb; float* xout32; float* ssq_out; float scale;
    DI void operator()(f32x4 (&acc)[2][2][4][2], const Unit& u, int wr, int wc, int fr, int fq) const {
        const int row0 = u.pm * 256 + wr * 64 + fr, col0 = u.pn * 256 + wc * 32 + 8 * fq;
        u32x4 cur[2], nxt[2];
        if (!xin32) {
#pragma unroll
            for (int bj = 0; bj < 2; ++bj) cur[bj] = *(const u32x4*)(xb + (size_t)row0 * DM + col0 + bj * 128);
        }
#pragma unroll
        for (int r = 0; r < 8; ++r) {
            const int ai = r >> 2, m = r & 3; const int row = row0 + ai * 128 + m * 16;
            f32x4 xo[2][2];
            if (xin32) {
#pragma unroll
                for (int bj = 0; bj < 2; ++bj) { const size_t off = (size_t)row * DM + col0 + bj * 128; xo[bj][0] = *(const f32x4*)(xin32 + off); xo[bj][1] = *(const f32x4*)(xin32 + off + 4); }
            } else {
                if (r < 7) { const int rown = row0 + ((r + 1) >> 2) * 128 + ((r + 1) & 3) * 16;
#pragma unroll
                    for (int bj = 0; bj < 2; ++bj) nxt[bj] = *(const u32x4*)(xb + (size_t)rown * DM + col0 + bj * 128); }
#pragma unroll
                for (int bj = 0; bj < 2; ++bj) { const u32x4 c = cur[bj];
                    xo[bj][0] = (f32x4){bflo(c.x), bfhi(c.x), bflo(c.y), bfhi(c.y)}; xo[bj][1] = (f32x4){bflo(c.z), bfhi(c.z), bflo(c.w), bfhi(c.w)}; }
            }
            float ss = 0.f;
#pragma unroll
            for (int bj = 0; bj < 2; ++bj) {
                const size_t off = (size_t)row * DM + col0 + bj * 128;
                const f32x4 a = xo[bj][0] + acc[ai][bj][m][0] * scale, b = xo[bj][1] + acc[ai][bj][m][1] * scale;
                *(u32x4*)(xb + off) = pack8(a, b);
                if (xout32) { *(f32x4*)(xout32 + off) = a; *(f32x4*)(xout32 + off + 4) = b; }
                ss += (a[0] * a[0] + a[1] * a[1]) + (a[2] * a[2] + a[3] * a[3]) + (b[0] * b[0] + b[1] * b[1]) + (b[2] * b[2] + b[3] * b[3]);
            }
            ss += __shfl_xor(ss, 16); ss += __shfl_xor(ss, 32);
            if (fq == 0) ssq_out[(size_t)row * 16 + u.pn * 4 + wc] = ss;
            if (!xin32 && r < 7) { cur[0] = nxt[0]; cur[1] = nxt[1]; }
        }
    }
};
DI void headnorm_store(const f32x4 (&z)[2][2], const f32x4 (&g)[2][2], float post, bf16_t* dst, int fq) {
    float ss = 0.f;
#pragma unroll
    for (int bj = 0; bj < 2; ++bj)
#pragma unroll
        for (int n = 0; n < 2; ++n) { const f32x4 t = z[bj][n]; ss += (t[0] * t[0] + t[1] * t[1]) + (t[2] * t[2] + t[3] * t[3]); }
    ss += __shfl_xor(ss, 16); ss += __shfl_xor(ss, 32);
    const float rn = rsqrtf(ss * (1.f / 64.f) + EPS) * post;
#pragma unroll
    for (int bj = 0; bj < 2; ++bj) *(u32x4*)(dst + 32 * bj + 8 * fq) = pack8(z[bj][0] * rn * g[bj][0], z[bj][1] * rn * g[bj][1]);
}
#define EPI_LOAD_GAIN(gv_, gain_) f32x4 gv_[2][2]; \
    _Pragma("unroll") for (int bj = 0; bj < 2; ++bj) { gv_[bj][0] = *(const f32x4*)((gain_) + 32 * bj + 8 * fq); gv_[bj][1] = *(const f32x4*)((gain_) + 32 * bj + 8 * fq + 4); }
#define EPI_Z() asm volatile("" ::: "memory"); f32x4 z[2][2]; \
    _Pragma("unroll") for (int bj = 0; bj < 2; ++bj) _Pragma("unroll") for (int n = 0; n < 2; ++n) z[bj][n] = acc[ai][bj][m][n] * rs[ai][m];
struct EpiInA {
    static constexpr bool PERM = true, AFTER_DRAIN = false;
    const float* ssq; bf16_t* QB; float* LF; bf16_t* VB; bf16_t* MIX; const float* lb; const float* mqgain; int pn_off;
    DI void operator()(f32x4 (&acc)[2][2][4][2], const Unit& u, int wr, int wc, int fr, int fq) const {
        const int t = u.pn + pn_off, row0 = u.pm * 256 + wr * 64 + fr, c8 = wc * 32 + 8 * fq;
        EPI_ROW_RSTD(ssq)
        EPI_LOAD_GAIN(gv, mqgain)
#pragma unroll
        for (int ai = 0; ai < 2; ++ai)
#pragma unroll
            for (int m = 0; m < 4; ++m) {
                const int row = row0 + ai * 128 + m * 16; EPI_Z()
                if (t < 3) {
#pragma unroll
                    for (int bj = 0; bj < 2; ++bj) { f32x4 a = z[bj][0], b = z[bj][1];
#pragma unroll
                        for (int e = 0; e < 4; ++e) { a[e] = silu_f(a[e]); b[e] = silu_f(b[e]); }
                        *(u32x4*)(QB + (size_t)row * 768 + t * 256 + bj * 128 + c8) = pack8(a, b); }
                } else if (t < 6) {
#pragma unroll
                    for (int bj = 0; bj < 2; ++bj) { const int col = (t - 3) * 256 + bj * 128 + c8;
                        const f32x4 l0 = *(const f32x4*)(lb + col), l1 = *(const f32x4*)(lb + col + 4); f32x4 a, b;
#pragma unroll
                        for (int e = 0; e < 4; ++e) {
                            const float la = logsig_f(z[bj][0][e]), lc = logsig_f(z[bj][1][e]);
                            a[e] = (l0[e] == 0.f) ? la : __logf(l0[e] + (1.f - l0[e]) * __expf(la));
                            b[e] = (l1[e] == 0.f) ? lc : __logf(l1[e] + (1.f - l1[e]) * __expf(lc));
                        }
                        *(f32x4*)(LF + (size_t)row * 768 + col) = a; *(f32x4*)(LF + (size_t)row * 768 + col + 4) = b; }
                } else if (t < 9) {
#pragma unroll
                    for (int bj = 0; bj < 2; ++bj) *(u32x4*)(VB + (size_t)row * 768 + (t - 6) * 256 + bj * 128 + c8) = pack8(z[bj][0], z[bj][1]);
                } else if (t < 12) {
#pragma unroll
                    for (int bj = 0; bj < 2; ++bj) { f32x4 a = z[bj][0], b = z[bj][1];
#pragma unroll
                        for (int e = 0; e < 4; ++e) { a[e] = silu_f(a[e]); b[e] = silu_f(b[e]); }
                        *(u32x4*)(MIX + (size_t)row * 1024 + (t - 9) * 256 + bj * 128 + c8) = pack8(a, b); }
                } else {
                    headnorm_store(z, gv, QSCALE, MIX + (size_t)row * 1024 + 768 + 64 * wc, fq);
                }
            }
    }
};
struct EpiInB {
    static constexpr bool PERM = true, AFTER_DRAIN = false;
    const float* ssq; bf16_t* QB; bf16_t* MIX; const float* fqgain; const float* mqgain;
    DI void operator()(f32x4 (&acc)[2][2][4][2], const Unit& u, int wr, int wc, int fr, int fq) const {
        const int t = u.pn, row0 = u.pm * 256 + wr * 64 + fr, c8 = wc * 32 + 8 * fq;
        EPI_ROW_RSTD(ssq)
        if (t < 3 || t == 6) {
            EPI_LOAD_GAIN(gv, (t < 3) ? fqgain : mqgain)
#pragma unroll
            for (int ai = 0; ai < 2; ++ai)
#pragma unroll
                for (int m = 0; m < 4; ++m) { const int row = row0 + ai * 128 + m * 16; EPI_Z()
                    headnorm_store(z, gv, QSCALE, (t < 3) ? QB + (size_t)row * 768 + t * 256 + 64 * wc : MIX + (size_t)row * 1024 + 768 + 64 * wc, fq); }
        } else {
#pragma unroll
            for (int ai = 0; ai < 2; ++ai)
#pragma unroll
                for (int m = 0; m < 4; ++m) { const int row = row0 + ai * 128 + m * 16; EPI_Z()
#pragma unroll
                    for (int bj = 0; bj < 2; ++bj) { f32x4 a = z[bj][0], b = z[bj][1];
#pragma unroll
                        for (int e = 0; e < 4; ++e) { a[e] = sigm_f(a[e]); b[e] = sigm_f(b[e]); }
                        *(u32x4*)(MIX + (size_t)row * 1024 + (t - 3) * 256 + bj * 128 + c8) = pack8(a, b); } }
        }
    }
};
struct EpiKV {
    static constexpr bool PERM = true, AFTER_DRAIN = false;
    const float* ssq; bf16_t* KSH; bf16_t* VSH; float* LFX; const float* kgain; const float* fbias;
    DI void operator()(f32x4 (&acc)[2][2][4][2], const Unit& u, int wr, int wc, int fr, int fq) const {
        const int t = u.pn, row0 = u.pm * 256 + wr * 64 + fr, c8 = wc * 32 + 8 * fq;
        EPI_ROW_RSTD(ssq)
        if (t < 3) {
            EPI_LOAD_GAIN(gv, kgain)
#pragma unroll
            for (int ai = 0; ai < 2; ++ai)
#pragma unroll
                for (int m = 0; m < 4; ++m) { const int row = row0 + ai * 128 + m * 16; EPI_Z()
                    headnorm_store(z, gv, 1.0f, KSH + (size_t)row * 768 + t * 256 + 64 * wc, fq); }
        } else if (t < 6) {
#pragma unroll
            for (int ai = 0; ai < 2; ++ai)
#pragma unroll
                for (int m = 0; m < 4; ++m) { const int row = row0 + ai * 128 + m * 16; EPI_Z()
#pragma unroll
                    for (int bj = 0; bj < 2; ++bj) *(u32x4*)(VSH + (size_t)row * 768 + (t - 3) * 256 + bj * 128 + c8) = pack8(z[bj][0], z[bj][1]); }
        } else if (wc == 0 && fq < 2) {
            float fb[2][4];
#pragma unroll
            for (int n = 0; n < 2; ++n)
#pragma unroll
                for (int e = 0; e < 4; ++e) { const int hh = 8 * fq + 4 * n + e; fb[n][e] = (hh < 12) ? fbias[hh] : 0.f; }
#pragma unroll
            for (int ai = 0; ai < 2; ++ai)
#pragma unroll
                for (int m = 0; m < 4; ++m) { const int row = row0 + ai * 128 + m * 16; EPI_Z()
                    const int b = row >> 11, sq = row & 2047;
#pragma unroll
                    for (int n = 0; n < 2; ++n)
#pragma unroll
                        for (int e = 0; e < 4; ++e) { const int hh = 8 * fq + 4 * n + e;
                            if (hh < 12) LFX[(size_t)(b * 12 + hh) * 2048 + sq] = logsig_f(z[0][n][e] + fb[n][e]); } }
        }
    }
};
struct EpiMemKV {
    static constexpr bool PERM = true, AFTER_DRAIN = false;
    const float* ssqm; bf16_t* MK; bf16_t* MV; const float* kgain_all;
    DI void operator()(f32x4 (&acc)[2][2][4][2], const Unit& u, int wr, int wc, int fr, int fq) const {
        const int l = u.pn >> 1, isv = u.pn & 1, row0 = u.pm * 256 + wr * 64 + fr, c8 = wc * 32 + 8 * fq;
        float rs[2][4];
#pragma unroll
        for (int ai = 0; ai < 2; ++ai)
#pragma unroll
            for (int m = 0; m < 4; ++m) rs[ai][m] = rsqrtf(ssqm[row0 + ai * 128 + m * 16] * (1.f / DM) + EPS);
        EPI_LOAD_GAIN(gv, kgain_all + 64 * l)
#pragma unroll
        for (int ai = 0; ai < 2; ++ai)
#pragma unroll
            for (int m = 0; m < 4; ++m) { const int row = row0 + ai * 128 + m * 16; EPI_Z()
                if (!isv) headnorm_store(z, gv, 1.0f, MK + ((size_t)l * MMEM + row) * 256 + 64 * wc, fq);
                else {
#pragma unroll
                    for (int bj = 0; bj < 2; ++bj) *(u32x4*)(MV + ((size_t)l * MMEM + row) * 256 + bj * 128 + c8) = pack8(z[bj][0], z[bj][1]); } }
    }
};

struct OneUnit {
    int pm;
    DI bool next(int i, Unit& u) const { if (i) return false; u.pm = pm; u.pn = 0; return true; }
    DI void a_ready(const Unit&) const {}
    DI void done(const Unit&) const {}
};
enum { MODE_NAT = 0, MODE_GU = 1, MODE_INA = 2, MODE_INB = 3, MODE_KV = 4, MODE_MEMKV = 5 };
DI void map_blk(int mode, int blk, int& scol, int& nvalid, int& which) {
    nvalid = 32; which = 0;
    const int tile = blk >> 3, j = blk & 7, pj = 64 * (j & 3) + 32 * (j >> 2);
    switch (mode) {
        case MODE_GU: which = j >> 2; scol = 128 * tile + 32 * (j & 3); break;
        case MODE_INA: scol = (tile == 12) ? 256 * tile + pj : 32 * blk; break;
        case MODE_INB: scol = (tile <= 2 || tile == 6) ? 256 * tile + pj : 32 * blk; break;
        case MODE_KV: if (tile <= 2) scol = 256 * tile + pj; else if (tile <= 5) scol = 32 * blk; else { scol = 1536; nvalid = (j == 0) ? 12 : 0; } break;
        case MODE_MEMKV: scol = (tile == 0) ? pj : 32 * blk; break;
        default: scol = 32 * blk; break;
    }
}
DI void conv_item(const float* W, int ldw, int K, bf16_t* WT, int dst_row0, int src_col0, int nvalid, const float* gain, int k0, LAS float* scr, int lane) {
    if (nvalid == 32) {
        const int kk0 = lane >> 3, n4 = lane & 7;
        f32x4 v[8];
#pragma unroll
        for (int i = 0; i < 8; ++i) v[i] = *(const f32x4*)(W + (size_t)(k0 + kk0 + 8 * i) * ldw + src_col0 + 4 * n4);
#pragma unroll
        for (int i = 0; i < 8; ++i) { LAS float* d = scr + (kk0 + 8 * i) * 33 + 4 * n4; d[0] = v[i][0]; d[1] = v[i][1]; d[2] = v[i][2]; d[3] = v[i][3]; }
    } else {
        const int c = lane & 31;
#pragma unroll 8
        for (int i = 0; i < 32; ++i) { const int kk = 2 * i + (lane >> 5);
            scr[kk * 33 + c] = (c < nvalid) ? W[(size_t)(k0 + kk) * ldw + src_col0 + c] : 0.f; }
    }
    asm volatile("s_waitcnt lgkmcnt(0)" ::: "memory");
    const int c8 = lane & 7;
    f32x4 g0 = (f32x4){1.f, 1.f, 1.f, 1.f}, g1 = g0;
    if (gain) { g0 = *(const f32x4*)(gain + k0 + 8 * c8); g1 = *(const f32x4*)(gain + k0 + 8 * c8 + 4); }
#pragma unroll
    for (int j = 0; j < 4; ++j) { const int n = (lane >> 3) + 8 * j; const LAS float* s = scr + (8 * c8) * 33 + n;
        u32x4 o; o.x = pk2(s[0 * 33] * g0[0], s[1 * 33] * g0[1]); o.y = pk2(s[2 * 33] * g0[2], s[3 * 33] * g0[3]); o.z = pk2(s[4 * 33] * g1[0], s[5 * 33] * g1[1]); o.w = pk2(s[6 * 33] * g1[2], s[7 * 33] * g1[3]);
        *(u32x4*)(WT + (size_t)(dst_row0 + n) * K + k0 + 8 * c8) = o; }
    asm volatile("s_waitcnt lgkmcnt(0)" ::: "memory");
}
DI void conv_job(int mode, const float* src, const float* src2, int ldw, int K, bf16_t* dst, int ndblk, const float* gain, int& base, int gw, int NGW, LAS float* scr, int lane) {
    const int nitems = ndblk * (K / 64);
    int it = gw - (base % NGW); if (it < 0) it += NGW;
    for (; it < nitems; it += NGW) {
        const int kb = it / ndblk, nb = it - kb * ndblk; int scol, nvalid, which;
        map_blk(mode, nb, scol, nvalid, which);
        conv_item(which ? src2 : src, ldw, K, dst, nb * 32, scol, nvalid, gain, kb * 64, scr, lane);
    }
    base += nitems;
}
DI void row_to_bf16(const float* xrow, bf16_t* orow, float* ssq1, int lane, bool slots) {
    const f32x4* xr = (const f32x4*)xrow + lane; f32x4 v[4]; float s = 0.f;
#pragma unroll
    for (int j = 0; j < 4; ++j) { v[j] = xr[64 * j]; s += (v[j][0] * v[j][0] + v[j][1] * v[j][1]) + (v[j][2] * v[j][2] + v[j][3] * v[j][3]); }
    s = wave_sum(s);
    u32x2* o8 = (u32x2*)orow + lane;
#pragma unroll
    for (int j = 0; j < 4; ++j) { u32x2 o; o.x = pk2(v[j][0], v[j][1]); o.y = pk2(v[j][2], v[j][3]); o8[64 * j] = o; }
    if (slots) { if (lane < 16) ssq1[lane] = lane ? 0.f : s; } else if (lane == 0) *ssq1 = s;
}


DI void conv_layer(const Params& p, unsigned char* ws, int l, int& base, int gw, int NGW, LAS float* scr, int lane) {
    conv_job(MODE_GU, p.in[3] + (size_t)l * DM * DFF, p.in[4] + (size_t)l * DM * DFF, DFF, DM, (bf16_t*)(ws + O_WGU1 + l * SZ_WGU), NGU / 32, p.in[2] + l * DM, base, gw, NGW, scr, lane);
    conv_job(MODE_NAT, p.in[5] + (size_t)l * DFF * DM, nullptr, DM, DFF, (bf16_t*)(ws + O_WD1 + l * SZ_WD), DM / 32, nullptr, base, gw, NGW, scr, lane);
    conv_job(MODE_GU, p.in[22] + (size_t)l * DM * DFF, p.in[23] + (size_t)l * DM * DFF, DFF, DM, (bf16_t*)(ws + O_WGU2 + l * SZ_WGU), NGU / 32, p.in[21] + l * DM, base, gw, NGW, scr, lane);
    conv_job(MODE_NAT, p.in[24] + (size_t)l * DFF * DM, nullptr, DM, DFF, (bf16_t*)(ws + O_WD2 + l * SZ_WD), DM / 32, nullptr, base, gw, NGW, scr, lane);
    conv_job(MODE_NAT, p.in[20] + (size_t)l * DM * DM, nullptr, DM, DM, (bf16_t*)(ws + O_WOUT + l * SZ_WOUT), DM / 32, nullptr, base, gw, NGW, scr, lane);
    if (l < 2) conv_job(MODE_INA, p.in[11] + (size_t)l * DM * NINA, nullptr, NINA, DM, (bf16_t*)(ws + O_WINA + l * SZ_WINA), NINA / 32, p.in[6] + l * DM, base, gw, NGW, scr, lane);
    else conv_job(MODE_INB, p.in[14] + (size_t)(l - 2) * DM * NINB, nullptr, NINB, DM, (bf16_t*)(ws + O_WINB + (l - 2) * SZ_WINB), NINB / 32, p.in[6] + l * DM, base, gw, NGW, scr, lane);
}
DI void hgrn_chain(const bf16_t* __restrict__ QB, const float* __restrict__ LF, const bf16_t* __restrict__ VB, const bf16_t* MIXG, bf16_t* MIX, const float* __restrict__ ogain, int b, int h, LAS unsigned char* lds) {
    int tid = threadIdx.x; asm volatile("" : "+v"(tid)); const int lane = tid & 63, w = __builtin_amdgcn_readfirstlane(tid >> 6), l15 = lane & 15, quad = lane >> 4;
    LAS bf16_t* QM = (LAS bf16_t*)lds; LAS bf16_t* KM = QM + 64 * 136; LAS bf16_t* QC = KM + 64 * 136; LAS bf16_t* KEt = QC + 64 * 136;
    LAS bf16_t* Vt = KEt + 128 * 72; LAS bf16_t* Pm = Vt + 128 * 72; LAS bf16_t* Sb = Pm + 64 * 72;
    LAS float* tot = (LAS float*)(Sb + 128 * 136); LAS float* cend = tot + 1024; LAS float* rss = cend + 128;
    for (int i = tid; i < 128 * 136 / 2; i += NTHREADS) ((LAS unsigned*)Sb)[i] = 0u;
    f32x4 S[8];
#pragma unroll
    for (int i = 0; i < 8; ++i) S[i] = (f32x4){0.f, 0.f, 0.f, 0.f};
    const size_t rowbase = (size_t)b * SEQ; const int hc = h * 128;
    const int tp = tid & 31, dvg = tid >> 5;
    f32x2 lf[8]; unsigned qv[8]; u32x4 vv0, vv1;
#define HG_LOAD(n_) do { const size_t r0_ = rowbase + (size_t)(n_) * 64; \
        _Pragma("unroll") for (int i = 0; i < 8; ++i) { const size_t r_ = r0_ + 8 * w + i; lf[i] = *(const f32x2*)(LF + r_ * 768 + hc + 2 * lane); qv[i] = *(const unsigned*)(QB + r_ * 768 + hc + 2 * lane); } \
        vv0 = *(const u32x4*)(VB + (r0_ + 2 * tp) * 768 + hc + 8 * dvg); vv1 = *(const u32x4*)(VB + (r0_ + 2 * tp + 1) * 768 + hc + 8 * dvg); } while (0)
    HG_LOAD(0);
    for (int n = 0; n < 32; ++n) {
        const int tt = w >> 1, dh = w & 1;
        const size_t r0 = rowbase + (size_t)n * 64;
        bf16_t gq[4][4];
#pragma unroll
        for (int i = 0; i < 4; ++i)
#pragma unroll
            for (int j = 0; j < 4; ++j) gq[i][j] = MIXG[(r0 + 16 * tt + 4 * quad + j) * 1024 + hc + 64 * dh + 16 * i + l15];
        float cx[8], cy[8]; float sx = 0.f, sy = 0.f;
#pragma unroll
        for (int i = 0; i < 8; ++i) { sx += lf[i].x; sy += lf[i].y; cx[i] = sx; cy[i] = sy; }
        *(LAS f32x2*)(tot + w * 128 + 2 * lane) = (f32x2){sx, sy};
        __syncthreads();
        float bx = 0.f, by = 0.f, mx = 0.f, my = 0.f, ex = 0.f, ey = 0.f;
#pragma unroll
        for (int g = 0; g < 8; ++g) { const f32x2 t2 = *(const LAS f32x2*)(tot + g * 128 + 2 * lane);
            if (g < w) { bx += t2.x; by += t2.y; } if (g < 4) { mx += t2.x; my += t2.y; } ex += t2.x; ey += t2.y; }
        if (w == 0) *(LAS f32x2*)(cend + 2 * lane) = (f32x2){ex, ey};
        float kex[8], key[8];
        const float emX = __expf(mx), emY = __expf(my), eeX = __expf(ex - mx), eeY = __expf(ey - my);
#pragma unroll
        for (int i = 0; i < 8; ++i) {
            const float cX = bx + cx[i], cY = by + cy[i];
            const float kX = 1.f - __expf(lf[i].x), kY = 1.f - __expf(lf[i].y);
            const float qX = bflo(qv[i]), qY = bfhi(qv[i]);
            const float dX = fminf(fmaxf(cX - mx, -80.f), 80.f), dY = fminf(fmaxf(cY - my, -80.f), 80.f);
            const int t = 8 * w + i;
            const float e1X = __expf(dX), e1Y = __expf(dY), e2X = __builtin_amdgcn_rcpf(e1X), e2Y = __builtin_amdgcn_rcpf(e1Y);
            const float qmX = qX * e1X, qmY = qY * e1Y, kmX = kX * e2X, kmY = kY * e2Y;
            *(LAS unsigned*)(QM + t * 136 + 2 * lane) = pk2(qmX, qmY);
            *(LAS unsigned*)(KM + t * 136 + 2 * lane) = pk2(kmX, kmY);
            *(LAS unsigned*)(QC + t * 136 + 2 * lane) = pk2(qmX * emX, qmY * emY);
            kex[i] = kmX * eeX; key[i] = kmY * eeY;
        }
        { u32x4 a, c2; a.x = pk2(kex[0], kex[1]); a.y = pk2(kex[2], kex[3]); a.z = pk2(kex[4], kex[5]); a.w = pk2(kex[6], kex[7]);
          c2.x = pk2(key[0], key[1]); c2.y = pk2(key[2], key[3]); c2.z = pk2(key[4], key[5]); c2.w = pk2(key[6], key[7]);
          *(LAS u32x4*)(KEt + (2 * lane) * 72 + 8 * w) = a; *(LAS u32x4*)(KEt + (2 * lane + 1) * 72 + 8 * w) = c2; }
#pragma unroll
        for (int i = 0; i < 8; ++i) { const unsigned a = vv0[i >> 1], c2 = vv1[i >> 1];
            const unsigned lo = (i & 1) ? (a >> 16) : (a & 0xffffu), hi = (i & 1) ? (c2 >> 16) : (c2 & 0xffffu);
            *(LAS unsigned*)(Vt + (8 * dvg + i) * 72 + 2 * tp) = lo | (hi << 16); }
        if (n + 1 < 32) HG_LOAD(n + 1);
        __syncthreads();
#pragma unroll
        for (int q = 0; q < 2; ++q) { const int idx = 2 * w + q, si = idx >> 2, ti = idx & 3;
            f32x4 a4 = (f32x4){0.f, 0.f, 0.f, 0.f};
            if (si <= ti) {
                bf16x8 ca[4], cb[4];
#pragma unroll
                for (int ks = 0; ks < 4; ++ks) { ca[ks] = *(const LAS bf16x8*)(KM + (16 * si + l15) * 136 + 32 * ks + 8 * quad); cb[ks] = *(const LAS bf16x8*)(QM + (16 * ti + l15) * 136 + 32 * ks + 8 * quad); }
__builtin_amdgcn_sched_barrier(0);
#pragma unroll
                for (int ks = 0; ks < 4; ++ks) a4 = MFMA16(ca[ks], cb[ks], a4);
                if (si == ti) {
#pragma unroll
                    for (int j = 0; j < 4; ++j) if (4 * quad + j > l15) a4[j] = 0.f; }
            }
            u32x2 pw; pw.x = pk2(a4[0], a4[1]); pw.y = pk2(a4[2], a4[3]);
            *(LAS u32x2*)(Pm + (16 * ti + l15) * 72 + 16 * si + 4 * quad) = pw; }
        __syncthreads();
        f32x4 o[4];
        { bf16x8 ap[2], aq[4];
#pragma unroll
          for (int ks = 0; ks < 2; ++ks) ap[ks] = *(const LAS bf16x8*)(Pm + (16 * tt + l15) * 72 + 32 * ks + 8 * quad);
#pragma unroll
          for (int ks = 0; ks < 4; ++ks) aq[ks] = *(const LAS bf16x8*)(QC + (16 * tt + l15) * 136 + 32 * ks + 8 * quad);
          bf16x8 bv[4][2], bs[4][4];
#pragma unroll
          for (int i = 0; i < 4; ++i) { const int dvr = 64 * dh + 16 * i + l15;
#pragma unroll
              for (int ks = 0; ks < 2; ++ks) bv[i][ks] = *(const LAS bf16x8*)(Vt + dvr * 72 + 32 * ks + 8 * quad);
#pragma unroll
              for (int ks = 0; ks < 4; ++ks) bs[i][ks] = *(const LAS bf16x8*)(Sb + dvr * 136 + 32 * ks + 8 * quad); }
#pragma unroll
          for (int i = 0; i < 4; ++i) o[i] = (f32x4){0.f, 0.f, 0.f, 0.f};
          __builtin_amdgcn_sched_barrier(0);
#pragma unroll
          for (int ks = 0; ks < 2; ++ks)
#pragma unroll
              for (int i = 0; i < 4; ++i) o[i] = MFMA16(ap[ks], bv[i][ks], o[i]);
#pragma unroll
          for (int ks = 0; ks < 4; ++ks)
#pragma unroll
              for (int i = 0; i < 4; ++i) o[i] = MFMA16(aq[ks], bs[i][ks], o[i]); }
        { f32x4 ss = o[0] * o[0] + o[1] * o[1] + o[2] * o[2] + o[3] * o[3];
#pragma unroll
          for (int j = 0; j < 4; ++j) { float v = ss[j]; v += __shfl_xor(v, 1); v += __shfl_xor(v, 2); v += __shfl_xor(v, 4); v += __shfl_xor(v, 8);
              if (l15 == 0) rss[(16 * tt + 4 * quad + j) * 2 + dh] = v; } }
        { bf16x8 ak[2];
#pragma unroll
          for (int ks = 0; ks < 2; ++ks) ak[ks] = *(const LAS bf16x8*)(KEt + (16 * w + l15) * 72 + 32 * ks + 8 * quad);
          f32x4 dec = *(const LAS f32x4*)(cend + 16 * w + 4 * quad);
#pragma unroll
          for (int j = 0; j < 4; ++j) dec[j] = __expf(dec[j]);
          bf16x8 ev[8][2];
#pragma unroll
          for (int dt = 0; dt < 8; ++dt)
#pragma unroll
              for (int ks = 0; ks < 2; ++ks) ev[dt][ks] = *(const LAS bf16x8*)(Vt + (16 * dt + l15) * 72 + 32 * ks + 8 * quad);
#pragma unroll
          for (int dt = 0; dt < 8; ++dt) S[dt] = S[dt] * dec;
          __builtin_amdgcn_sched_barrier(0);
#pragma unroll
          for (int ks = 0; ks < 2; ++ks)
#pragma unroll
              for (int dt = 0; dt < 8; ++dt) S[dt] = MFMA16(ak[ks], ev[dt][ks], S[dt]); }
        __syncthreads();
        float rsn[4];
#pragma unroll
        for (int j = 0; j < 4; ++j) { const f32x2 r2 = *(const LAS f32x2*)(rss + 2 * (16 * tt + 4 * quad + j)); rsn[j] = rsqrtf((r2.x + r2.y) * (1.f / 128.f) + EPS); }
#pragma unroll
        for (int i = 0; i < 4; ++i) { const float og = ogain[64 * dh + 16 * i + l15];
#pragma unroll
            for (int j = 0; j < 4; ++j) { const float val = o[i][j] * rsn[j] * og * bf1(gq[i][j]);
                MIX[(r0 + 16 * tt + 4 * quad + j) * 1024 + hc + 64 * dh + 16 * i + l15] = (bf16_t)(pk2(val, 0.f) & 0xffffu); } }
#pragma unroll
        for (int dt = 0; dt < 8; ++dt) { u32x2 sw; sw.x = pk2(S[dt][0], S[dt][1]); sw.y = pk2(S[dt][2], S[dt][3]);
            *(LAS u32x2*)(Sb + (16 * dt + l15) * 136 + 16 * w + 4 * quad) = sw; }
    }
#undef HG_LOAD
    __syncthreads();
}

DI void attn_item(const bf16_t* Qp, int ldq, const bf16_t* __restrict__ Kp, const bf16_t* __restrict__ Vp, int ldkv, int nkv, const float* __restrict__ bias, int q0, bool causal,
                  const bf16_t* Gp, bf16_t* Op, int ldo, bool gated, LAS unsigned char* lds) {
    int tid = threadIdx.x; asm volatile("" : "+v"(tid)); const int lane = tid & 63, w = __builtin_amdgcn_readfirstlane(tid >> 6), l15 = lane & 15, quad = lane >> 4;
    constexpr int ABUF = 64 * 72 * 2 * 2 + 256;
    bf16x8 bq[2][2];
#pragma unroll
    for (int qt = 0; qt < 2; ++qt)
#pragma unroll
        for (int ks = 0; ks < 2; ++ks) bq[qt][ks] = *(const bf16x8*)(Qp + (size_t)(32 * w + 16 * qt + l15) * ldq + 32 * ks + 8 * quad);
    const float dref = bias ? bias[q0] : 0.f;
    float mrun[2] = {-INFINITY, -INFINITY}, lsum[2] = {0.f, 0.f};
    f32x4 o[2][4];
#pragma unroll
    for (int qt = 0; qt < 2; ++qt)
#pragma unroll
        for (int dt = 0; dt < 4; ++dt) o[qt][dt] = (f32x4){0.f, 0.f, 0.f, 0.f};
    const int key_l = tid >> 3, ch = tid & 7, kp = tid >> 4, dvg = tid & 15;
    u32x4 kreg; u32x2 v0, v1; float breg = 0.f;
#define AT_LOAD(kt_) do { const size_t kr_ = (size_t)(kt_) * 64; kreg = *(const u32x4*)(Kp + (kr_ + key_l) * ldkv + 8 * ch); \
        v0 = *(const u32x2*)(Vp + (kr_ + 2 * kp) * ldkv + 4 * dvg); v1 = *(const u32x2*)(Vp + (kr_ + 2 * kp + 1) * ldkv + 4 * dvg); \
        if (tid < 64) breg = bias ? (dref - bias[kr_ + tid]) : 0.f; } while (0)
#define AT_STORE(buf_) do { LAS bf16_t* Ks_ = (LAS bf16_t*)(lds + (buf_) * ABUF); LAS bf16_t* Vt_ = Ks_ + 64 * 72; LAS float* bl_ = (LAS float*)(Vt_ + 64 * 72); \
        *(LAS u32x4*)(Ks_ + key_l * 72 + 8 * ch) = kreg; \
        _Pragma("unroll") for (int i = 0; i < 4; ++i) { const unsigned a = v0[i >> 1], c2 = v1[i >> 1]; \
            const unsigned lo = (i & 1) ? (a >> 16) : (a & 0xffffu), hi = (i & 1) ? (c2 >> 16) : (c2 & 0xffffu); \
            *(LAS unsigned*)(Vt_ + (4 * dvg + i) * 72 + 2 * kp) = lo | (hi << 16); } \
        if (tid < 64) bl_[tid] = breg; } while (0)
    AT_LOAD(0);
    const int qlo = q0 + 32 * w;
    AT_STORE(0);
    __syncthreads();
    for (int kt = 0; kt < nkv; ++kt) {
        if (kt) { AT_STORE(kt & 1); __syncthreads(); }
        if (kt + 1 < nkv) AT_LOAD(kt + 1);
        if (causal && 64 * kt > qlo + 31) continue;
        const LAS bf16_t* Ks = (const LAS bf16_t*)(lds + (kt & 1) * ABUF); const LAS bf16_t* Vt = Ks + 64 * 72; const LAS float* bl = (const LAS float*)(Vt + 64 * 72);
        f32x4 s[2][4];
        { bf16x8 ka[4][2]; f32x4 kb[4];
#pragma unroll
          for (int ky = 0; ky < 4; ++ky) { ka[ky][0] = *(const LAS bf16x8*)(Ks + (16 * ky + l15) * 72 + 8 * quad); ka[ky][1] = *(const LAS bf16x8*)(Ks + (16 * ky + l15) * 72 + 32 + 8 * quad);
              kb[ky] = *(const LAS f32x4*)(bl + 16 * ky + 4 * quad); }
          __builtin_amdgcn_sched_barrier(0);
#pragma unroll
          for (int ky = 0; ky < 4; ++ky)
#pragma unroll
              for (int qt = 0; qt < 2; ++qt) s[qt][ky] = MFMA16(ka[ky][0], bq[qt][0], kb[ky]);
#pragma unroll
          for (int ky = 0; ky < 4; ++ky)
#pragma unroll
              for (int qt = 0; qt < 2; ++qt) s[qt][ky] = MFMA16(ka[ky][1], bq[qt][1], s[qt][ky]); }
        if (causal && 64 * kt + 63 > qlo) {
#pragma unroll
            for (int qt = 0; qt < 2; ++qt)
#pragma unroll
                for (int ky = 0; ky < 4; ++ky)
#pragma unroll
                    for (int j = 0; j < 4; ++j) if (64 * kt + 16 * ky + 4 * quad + j > qlo + 16 * qt + l15) s[qt][ky][j] = -INFINITY;
        }
#pragma unroll
        for (int qt = 0; qt < 2; ++qt) {
            float tm = -INFINITY;
#pragma unroll
            for (int ky = 0; ky < 4; ++ky) tm = fmaxf(tm, fmaxf(fmaxf(s[qt][ky][0], s[qt][ky][1]), fmaxf(s[qt][ky][2], s[qt][ky][3])));
            tm = fmaxf(tm, __shfl_xor(tm, 16)); tm = fmaxf(tm, __shfl_xor(tm, 32));
            const float mn = fmaxf(mrun[qt], tm);
            const float alpha = __builtin_amdgcn_exp2f(mrun[qt] - mn);
            mrun[qt] = mn; float ps = 0.f;
#pragma unroll
            for (int ky = 0; ky < 4; ++ky)
#pragma unroll
                for (int j = 0; j < 4; ++j) { const float pv = __builtin_amdgcn_exp2f(s[qt][ky][j] - mn); s[qt][ky][j] = pv; ps += pv; }
            lsum[qt] = lsum[qt] * alpha + ps;
#pragma unroll
            for (int dt = 0; dt < 4; ++dt) o[qt][dt] *= alpha;
        }
#pragma unroll
        for (int ks2 = 0; ks2 < 2; ++ks2) {
            bf16x8 pb[2];
#pragma unroll
            for (int qt = 0; qt < 2; ++qt) { u32x4 pw; pw.x = pk2(s[qt][2 * ks2][0], s[qt][2 * ks2][1]); pw.y = pk2(s[qt][2 * ks2][2], s[qt][2 * ks2][3]);
                pw.z = pk2(s[qt][2 * ks2 + 1][0], s[qt][2 * ks2 + 1][1]); pw.w = pk2(s[qt][2 * ks2 + 1][2], s[qt][2 * ks2 + 1][3]); pb[qt] = __builtin_bit_cast(bf16x8, pw); }
            bf16x8 va[4];
#pragma unroll
            for (int dt = 0; dt < 4; ++dt) { const u32x2 lo = *(const LAS u32x2*)(Vt + (16 * dt + l15) * 72 + 32 * ks2 + 4 * quad), hi = *(const LAS u32x2*)(Vt + (16 * dt + l15) * 72 + 32 * ks2 + 16 + 4 * quad);
                u32x4 av; av.x = lo.x; av.y = lo.y; av.z = hi.x; av.w = hi.y; va[dt] = __builtin_bit_cast(bf16x8, av); }
            __builtin_amdgcn_sched_barrier(0);
#pragma unroll
            for (int dt = 0; dt < 4; ++dt)
#pragma unroll
                for (int qt = 0; qt < 2; ++qt) o[qt][dt] = MFMA16(va[dt], pb[qt], o[qt][dt]);
        }
    }
#undef AT_LOAD
#undef AT_STORE
#pragma unroll
    for (int qt = 0; qt < 2; ++qt) {
        float l = lsum[qt]; l += __shfl_xor(l, 16); l += __shfl_xor(l, 32);
        const float inv = 1.f / l;
        bf16_t* orow = Op + (size_t)(32 * w + 16 * qt + l15) * ldo + 4 * quad; const bf16_t* grow = Gp + (size_t)(32 * w + 16 * qt + l15) * ldo + 4 * quad;
#pragma unroll
        for (int dt = 0; dt < 4; ++dt) { f32x4 v = o[qt][dt] * inv;
            if (gated) { const u32x2 g = *(const u32x2*)(grow + 16 * dt); v[0] *= bflo(g.x); v[1] *= bfhi(g.x); v[2] *= bflo(g.y); v[3] *= bfhi(g.y); }
            u32x2 ow; ow.x = pk2(v[0], v[1]); ow.y = pk2(v[2], v[3]); *(u32x2*)(orow + 16 * dt) = ow; }
    }
    __syncthreads();
}
DI void fox_cumsum(const float* LFX, float* DL, int bh, int lane) {
    const float* src = LFX + (size_t)bh * 2048 + 32 * lane; float v[32]; float s = 0.f;
#pragma unroll
    for (int i = 0; i < 8; ++i) { const f32x4 t = *(const f32x4*)(src + 4 * i);
#pragma unroll
        for (int e = 0; e < 4; ++e) { s += t[e]; v[4 * i + e] = s; } }
    float incl = s;
#pragma unroll
    for (int off = 1; off < 64; off <<= 1) { const float t = __shfl_up(incl, off); if (lane >= off) incl += t; }
    const float excl = incl - s;
    float* dst = DL + (size_t)bh * 2048 + 32 * lane;
#pragma unroll
    for (int i = 0; i < 8; ++i) { f32x4 t;
#pragma unroll
        for (int e = 0; e < 4; ++e) t[e] = (v[4 * i + e] + excl) * LOG2E;
        *(f32x4*)(dst + 4 * i) = t; }
}
DI void mem_attn_item(int j, int l, bf16_t* MIX, const bf16_t* MK, const bf16_t* MV, LAS unsigned char* lds) {
    const int b = j >> 5, qb = (j >> 2) & 7, hd = j & 3;
    bf16_t* qo = MIX + ((size_t)b * SEQ + 256 * qb) * 1024 + 768 + 64 * hd;
    const size_t kvoff = ((size_t)l * MMEM + (size_t)b * NMEMT) * 256 + 64 * hd;
    attn_item(qo, 1024, MK + kvoff, MV + kvoff, 256, 4, nullptr, 0, false, qo, qo, 1024, false, lds);
}


typedef unsigned v4u __attribute__((ext_vector_type(4)));
#define XB_TMO      128
#define XB_XCNT(j)  (256  + 64 * (j))
#define XB_XSUB(j)  (1280 + 64 * (j))
#define XB_XGEN(j)  (2304 + 64 * (j))
#define XB_TOP      3328
#define XB_TOPGEN   3392
#define XCD_BAR_WORDS 3456
#define XB_SPIN_CAP (1u << 18)

__device__ __forceinline__ unsigned xb_ld(unsigned* p)              { return __hip_atomic_load(p, __ATOMIC_RELAXED, __HIP_MEMORY_SCOPE_AGENT); }
__device__ __forceinline__ unsigned xb_add(unsigned* p, unsigned v) { return __hip_atomic_fetch_add(p, v, __ATOMIC_RELAXED, __HIP_MEMORY_SCOPE_AGENT); }
__device__ __forceinline__ unsigned xb_xcc_id() { return (unsigned)__builtin_amdgcn_s_getreg((3 << 11) | 20) & 0xFu; }
#define XB_SPIN(cond, bar) do { unsigned _sp = 0; while (cond) { __builtin_amdgcn_s_sleep(1); \
    if ((++_sp & 255u) == 0u) { if (xb_ld(&(bar)[XB_TMO])) break; if (_sp > XB_SPIN_CAP) { atomicAdd(&(bar)[XB_TMO], 1u); break; } } } } while (0)

struct XcdBarrier {
    unsigned* bar; unsigned x;
    volatile LAS unsigned* st;
};

__device__ __forceinline__ XcdBarrier xcd_barrier_post(unsigned* bar, volatile LAS unsigned* st) {
    XcdBarrier b; b.bar = bar; b.x = xb_xcc_id(); b.st = st;
    if (threadIdx.x == 0) (void)xb_add(&bar[XB_XCNT(b.x)], 1u);
    return b;
}
__device__ __forceinline__ void xcd_barrier_complete(unsigned* bar, unsigned x, unsigned& nloc, unsigned& nx) {
    const unsigned G = gridDim.x * gridDim.y * gridDim.z;
    unsigned sum, cnt, mine, sp = 0u;
    for (;;) {
        sum = 0u; cnt = 0u; mine = 0u;
#pragma unroll
        for (unsigned j = 0; j < 16; ++j) { const unsigned c = xb_ld(&bar[XB_XCNT(j)]); sum += c; cnt += (c > 0u) ? 1u : 0u; mine = (j == x) ? c : mine; }
        if (sum == G) break;
        __builtin_amdgcn_s_sleep(1);
        if ((++sp & 255u) == 0u) { if (xb_ld(&bar[XB_TMO])) break; if (sp > XB_SPIN_CAP) { atomicAdd(&bar[XB_TMO], 1u); break; } }
    }
    nloc = mine > 0u ? mine : 1u; nx = cnt > 0u ? cnt : 1u;
}

__device__ __forceinline__ void xcd_barrier(const XcdBarrier& b) {
    asm volatile("s_waitcnt vmcnt(0)" ::: "memory");
    __syncthreads();
    if (threadIdx.x == 0) {
        unsigned* bar = b.bar;
        __builtin_amdgcn_s_waitcnt(0);
        unsigned nloc = b.st[0], nx = b.st[1];
        if (nloc == 0u) { xcd_barrier_complete(bar, b.x, nloc, nx); b.st[0] = nloc; b.st[1] = nx; }
        const unsigned old = xb_add(&bar[XB_XSUB(b.x)], 1u);
        const unsigned gen = old / nloc;
        if (old + 1u == (gen + 1u) * nloc) {
            __builtin_amdgcn_fence(__ATOMIC_RELEASE, "agent");
            asm volatile("s_waitcnt vmcnt(0)" ::: "memory");
            const unsigned og = xb_add(&bar[XB_TOP], 1u);
            const unsigned tg = og / nx;
            if (og + 1u == (tg + 1u) * nx) xb_add(&bar[XB_TOPGEN], 1u);
            else XB_SPIN(xb_ld(&bar[XB_TOPGEN]) == tg, bar);
            __builtin_amdgcn_fence(__ATOMIC_ACQUIRE, "agent");
            xb_add(&bar[XB_XGEN(b.x)], 1u);
            asm volatile("s_waitcnt vmcnt(0)" ::: "memory");
        } else {
            XB_SPIN(xb_ld(&bar[XB_XGEN(b.x)]) == gen, bar);
            __builtin_amdgcn_fence(__ATOMIC_ACQUIRE, "agent");
            asm volatile("s_waitcnt vmcnt(0)" ::: "memory");
        }
    }
    __syncthreads();
}

#define GRID_SYNC0() do { asm volatile("s_waitcnt vmcnt(0)" ::: "memory"); __syncthreads(); grid.sync(); __builtin_amdgcn_fence(__ATOMIC_ACQUIRE, "agent"); asm volatile("s_waitcnt vmcnt(0)" ::: "memory"); __syncthreads(); } while (0)
#define GRID_SYNC() do { XcdBarrier b_; b_.bar = (unsigned*)(wsp(p) + O_BAR); b_.x = xbar_x; asm volatile("" : "+s"(b_.x)); b_.st = (volatile LAS unsigned*)(lds + LDS_BARST); xcd_barrier(b_); } while (0)
DI unsigned char* wsp(const Params& p) { size_t z_ = 0; asm volatile("" : "+s"(z_)); return p.ws + z_; }
#define WSPTRS unsigned char* ws = wsp(p); int L_ = l, H_ = half; asm volatile("" : "+s"(L_), "+s"(H_)); (void)L_; (void)H_; bf16_t* XB = (bf16_t*)(ws + O_XB); bf16_t* ACT = (bf16_t*)(ws + O_ACT); bf16_t* QB = (bf16_t*)(ws + O_QB); float* LF = (float*)(ws + O_LF); \
    bf16_t* VB = (bf16_t*)(ws + O_VB); bf16_t* MIX = (bf16_t*)(ws + O_MIX); bf16_t* KSH = (bf16_t*)(ws + O_KSH); bf16_t* VSH = (bf16_t*)(ws + O_VSH); \
    float* LFX = (float*)(ws + O_LFX); float* DL = (float*)(ws + O_DL); bf16_t* MEMB = (bf16_t*)(ws + O_MEMB); bf16_t* MK = (bf16_t*)(ws + O_MK); bf16_t* MV = (bf16_t*)(ws + O_MV); \
    float* SSQ = (float*)(ws + O_SSQ); float* SSQM = (float*)(ws + O_SSQM); float* LBV = (float*)(ws + O_LBV); float* OUT = p.out; \
    (void)XB;(void)ACT;(void)QB;(void)LF;(void)VB;(void)MIX;(void)KSH;(void)VSH;(void)LFX;(void)DL;(void)MEMB;(void)MK;(void)MV;(void)SSQ;(void)SSQM;(void)LBV;(void)OUT;
__global__ void __launch_bounds__(NTHREADS) fwd_kernel(Params p) {
    extern __shared__ __attribute__((aligned(16))) unsigned char lds_raw[];
    LAS unsigned char* lds = (LAS unsigned char*)lds_raw;
    cg::grid_group grid = cg::this_grid();
    const int G = gridDim.x, blk = blockIdx.x, tid = threadIdx.x, lane = tid & 63, w = __builtin_amdgcn_readfirstlane(tid >> 6);

    if (tid < 16) ((LAS unsigned*)(lds + LDS_BARST))[tid] = 0u;
    __syncthreads();
    const unsigned xbar_x = xcd_barrier_post((unsigned*)(p.ws + O_BAR), (volatile LAS unsigned*)(lds + LDS_BARST)).x;
    {   const int l = 0, half = 0; WSPTRS
        LAS float* scr = (LAS float*)(lds + w * 16384);
        const int gw = blk * 8 + w, NGW = G * 8; int base = 0;
        conv_layer(p, ws, 0, base, gw, NGW, scr, lane);
        for (int l2 = 0; l2 < 4; ++l2) conv_job(MODE_MEMKV, p.in[8] + (size_t)l2 * DM * 512, nullptr, 512, DM, (bf16_t*)(ws + O_WMKV) + (size_t)l2 * 512 * DM, 16, p.in[7] + l2 * DM, base, gw, NGW, scr, lane);
        for (int m = gw; m < MTOK; m += NGW) row_to_bf16(p.in[0] + (size_t)m * DM, XB + (size_t)m * DM, SSQ + (size_t)m * 16, lane, true);
        for (int m = gw; m < MMEM; m += NGW) row_to_bf16(p.in[1] + (size_t)m * DM, MEMB + (size_t)m * DM, SSQM + m, lane, false);
        const int gt = blk * NTHREADS + tid;
        if (gt < 768) { LBV[gt] = 0.f; LBV[768 + gt] = 1.f / (1.f + __expf(p.in[12][gt] - p.in[12][768 + gt])); }
    }
    { int never_ = 0; asm volatile("" : "+s"(never_)); if (never_) GRID_SYNC0(); }
    GRID_SYNC();

    for (int l = 0; l < 4; ++l) {
        for (int half = 0; half < 2; ++half) {
            if (l == 2 && half == 0) { int t2 = threadIdx.x; asm volatile("" : "+v"(t2)); if ((t2 >> 6) == 0) { WSPTRS for (int bh = blk; bh < 96; bh += G) fox_cumsum(LFX, DL, bh, t2 & 63); } }
            {
                WSPTRS const bf16_t* Wgu = (const bf16_t*)(ws + (H_ ? O_WGU2 : O_WGU1) + L_ * SZ_WGU);
                pg8::Gemm g{XB, Wgu, MTOK, NGU, DM}; pg8::StaticOrder S; S.init(MTOK, NGU, G, blk);
                EpiGateUp E{ACT, SSQ};
                pg8::gemm_phase<EpiGateUp, pg8::StaticOrder, true, true>(lds, g, S, E);
            }
            if (l == 0 && half == 0) {
                WSPTRS const int nfull = ((MTOK / 256) * (NGU / 256)) % G;
                pg8::Gemm g{MEMB, (const bf16_t*)(ws + O_WMKV), MMEM, NMKV, DM}; pg8::StaticOrder S; S.init(MMEM, NMKV, G, (blk - nfull + G) % G);
                EpiMemKV E{SSQM, MK, MV, p.in[10]};
                pg8::gemm_phase<EpiMemKV, pg8::StaticOrder, true, true>(lds, g, S, E);
            }
            GRID_SYNC();
            {
                WSPTRS const bf16_t* Wd = (const bf16_t*)(ws + (H_ ? O_WD2 : O_WD1) + L_ * SZ_WD);
                pg8::Gemm g{ACT, Wd, MTOK, DM, DFF}; pg8::StaticOrder S; S.init(MTOK, DM, G, blk);
                EpiResid E{(L_ == 0 && H_ == 0) ? p.in[0] : nullptr, XB, (L_ == 3 && H_ == 1) ? OUT : nullptr, SSQ, 0.5f};
                pg8::gemm_phase<EpiResid, pg8::StaticOrder, true, true>(lds, g, S, E);
            }
            if (l == 3 && half == 1) break;
            GRID_SYNC();
            if (half == 0) {
                if (l < 2) {
                    {   WSPTRS pg8::Gemm g{XB, (const bf16_t*)(ws + O_WINA + L_ * SZ_WINA), MTOK, NINA - 256, DM}; pg8::StaticOrder S; S.init(MTOK, NINA - 256, G, blk);
                        EpiInA E{SSQ, QB, LF, VB, MIX, LBV + L_ * 768, p.in[9] + L_ * 64, 0};
                        pg8::gemm_phase<EpiInA, pg8::StaticOrder, true, true>(lds, g, S, E); }
                    GRID_SYNC();
                    { WSPTRS
                    for (int c = blk; c < 48; c += G) hgrn_chain(QB, LF, VB, MIX, MIX, p.in[13] + L_ * 128, c / 6, c % 6, lds);
                    if (G > 48) { if (blk >= 48) {
                        for (int pm = blk - 48; pm < 64; pm += G - 48) {
                            pg8::Gemm g{XB, (const bf16_t*)(ws + O_WINA + L_ * SZ_WINA) + (size_t)(NINA - 256) * DM, MTOK, 256, DM}; OneUnit S1{pm};
                            EpiInA E{SSQ, QB, LF, VB, MIX, LBV + L_ * 768, p.in[9] + L_ * 64, 12};
                            pg8::gemm_phase<EpiInA, OneUnit, true, true>(lds, g, S1, E);
                            asm volatile("s_waitcnt vmcnt(0)" ::: "memory"); __syncthreads();
                            for (int hd = 0; hd < 4; ++hd) mem_attn_item(pm * 4 + hd, L_, MIX, MK, MV, lds);
                        }
                        int tq = threadIdx.x; asm volatile("" : "+v"(tq)); const int wq = __builtin_amdgcn_readfirstlane(tq >> 6);
                        LAS float* scr = (LAS float*)(lds + wq * 16384); const int gw = (blk - 48) * 8 + wq, NGW = (G - 48) * 8; int base = 0;
                        if (L_ == 0) { conv_layer(p, ws, 1, base, gw, NGW, scr, tq & 63); conv_layer(p, ws, 2, base, gw, NGW, scr, tq & 63); }
                        else { conv_layer(p, ws, 3, base, gw, NGW, scr, tq & 63); conv_job(MODE_KV, p.in[17], nullptr, KVSRC, DM, (bf16_t*)(ws + O_WKV), NKV / 32, p.in[16], base, gw, NGW, scr, tq & 63); }
                        __syncthreads(); } }
                    else { for (int pm = blk; pm < 64; pm += G) {
                            pg8::Gemm g{XB, (const bf16_t*)(ws + O_WINA + L_ * SZ_WINA) + (size_t)(NINA - 256) * DM, MTOK, 256, DM}; OneUnit S1{pm};
                            EpiInA E{SSQ, QB, LF, VB, MIX, LBV + L_ * 768, p.in[9] + L_ * 64, 12};
                            pg8::gemm_phase<EpiInA, OneUnit, true, true>(lds, g, S1, E);
                            asm volatile("s_waitcnt vmcnt(0)" ::: "memory"); __syncthreads();
                            for (int hd = 0; hd < 4; ++hd) mem_attn_item(pm * 4 + hd, L_, MIX, MK, MV, lds);
                        }
                        int tq = threadIdx.x; asm volatile("" : "+v"(tq)); const int wq = __builtin_amdgcn_readfirstlane(tq >> 6);
                        LAS float* scr = (LAS float*)(lds + wq * 16384); const int gw = blk * 8 + wq, NGW = G * 8; int base = 0;
                        if (L_ == 0) { conv_layer(p, ws, 1, base, gw, NGW, scr, tq & 63); conv_layer(p, ws, 2, base, gw, NGW, scr, tq & 63); }
                        else { conv_layer(p, ws, 3, base, gw, NGW, scr, tq & 63); conv_job(MODE_KV, p.in[17], nullptr, KVSRC, DM, (bf16_t*)(ws + O_WKV), NKV / 32, p.in[16], base, gw, NGW, scr, tq & 63); }
                        __syncthreads(); } }
                } else {
                    {   WSPTRS pg8::Gemm g{XB, (const bf16_t*)(ws + O_WINB + (L_ - 2) * SZ_WINB), MTOK, NINB, DM}; pg8::StaticOrder S; S.init(MTOK, NINB, G, blk);
                        EpiInB E{SSQ, QB, MIX, p.in[15] + (L_ - 2) * 64, p.in[9] + L_ * 64};
                        pg8::gemm_phase<EpiInB, pg8::StaticOrder, true, true>(lds, g, S, E); }
                    GRID_SYNC();
                    { WSPTRS
                    for (int r = 0;; ++r) {
                        const int idx = r * G + ((r & 1) ? (G - 1 - blk) : blk);
                        if (r * G >= 1024) break;
                        if (idx >= 1024) continue;
                        if (idx < 768) { const int qb = 7 - idx / 96, bh = idx % 96, b = bh / 12, h = bh % 12;
                            bf16_t* op = MIX + ((size_t)b * SEQ + 256 * qb) * 1024 + 64 * h;
                            attn_item(QB + ((size_t)b * SEQ + 256 * qb) * 768 + 64 * h, 768, KSH + (size_t)b * SEQ * 768 + 64 * h, VSH + (size_t)b * SEQ * 768 + 64 * h, 768, 4 * (qb + 1),
                                      DL + (size_t)bh * 2048, 256 * qb, true, op, op, 1024, true, lds);
                        } else mem_attn_item(idx - 768, L_, MIX, MK, MV, lds);
                    } }
                }
                GRID_SYNC();
                {
                    WSPTRS pg8::Gemm g{MIX, (const bf16_t*)(ws + O_WOUT + L_ * SZ_WOUT), MTOK, DM, DM}; pg8::StaticOrder S; S.init(MTOK, DM, G, blk);
                    EpiResid E{nullptr, XB, nullptr, SSQ, 1.0f};
                    pg8::gemm_phase<EpiResid, pg8::StaticOrder, true, true>(lds, g, S, E);
                }
                GRID_SYNC();
            }
        }
        if (l == 1) {
            const int half = 0; WSPTRS pg8::Gemm g{XB, (const bf16_t*)(ws + O_WKV), MTOK, NKV, DM}; pg8::StaticOrder S; S.init(MTOK, NKV, G, blk);
            EpiKV E{SSQ, KSH, VSH, LFX, p.in[19], p.in[18]};
            pg8::gemm_phase<EpiKV, pg8::StaticOrder, true, true>(lds, g, S, E);
            GRID_SYNC();
        }
    }
}

extern "C" void kernel_launch(void* const* d_in, const int* in_sizes, int n_in, void* d_out, int out_size, void* d_ws, size_t ws_size, hipStream_t stream) {
    static int grid = 0;
    if (grid == 0) {
        if (n_in != 25 || out_size != MTOK * DM || ws_size < WS_END) { fprintf(stderr, "kernel_launch: unexpected problem (n_in %d, out %d, ws %zu, need %zu)\n", n_in, out_size, ws_size, (size_t)WS_END); grid = -1; return; }
        int dev = 0, cus = 0, per_cu = 0;
        (void)hipGetDevice(&dev); (void)hipDeviceGetAttribute(&cus, hipDeviceAttributeMultiprocessorCount, dev);
        (void)hipFuncSetAttribute((const void*)fwd_kernel, hipFuncAttributeMaxDynamicSharedMemorySize, LDS_BYTES);
        if (hipOccupancyMaxActiveBlocksPerMultiprocessor(&per_cu, (const void*)fwd_kernel, NTHREADS, LDS_BYTES) != hipSuccess || per_cu < 1) per_cu = 1;
        (void)hipGetLastError();
        grid = cus * per_cu; if (grid < 1) grid = 256;
    }
    if (grid < 0) return;
    Params p{};
    for (int i = 0; i < 25; ++i) p.in[i] = (const float*)d_in[i];
    p.out = (float*)d_out; p.ws = (unsigned char*)d_ws;
    if (hipMemsetAsync((unsigned char*)d_ws + O_BAR, 0, XCD_BAR_WORDS_C * 4, stream) != hipSuccess) { fprintf(stderr, "kernel_launch: memset of the barrier words failed\n"); return; }
    void* args[] = {&p};
    hipError_t e = hipLaunchCooperativeKernel((const void*)fwd_kernel, dim3(grid), dim3(NTHREADS), args, LDS_BYTES, stream);
    if (e != hipSuccess) fprintf(stderr, "cooperative launch failed: %s (grid %d)\n", hipGetErrorString(e), grid);
}
```

```cpp
#include <hip/hip_runtime.h>
#include <hip/hip_cooperative_groups.h>
#include <cstdio>
#include <cstdint>
namespace cg = cooperative_groups;
namespace pg8 {
#define PG8_LAS __attribute__((address_space(3)))
typedef unsigned short bf16_t;
typedef short bf16x8 __attribute__((ext_vector_type(8)));
typedef float f32x4 __attribute__((ext_vector_type(4)));
typedef unsigned u32x4 __attribute__((ext_vector_type(4)));
constexpr int BM = 256, BK = 64, HALF = 128, HTB = HALF * BK * 2  , STAGE_BYTES = 8 * HTB, NXCD = 8, WGM = 4;

__host__ __device__ __forceinline__ int lds_byte(int r, int c) { const int st = (r >> 4) * 2 + (c >> 5), rr = r & 15, cc = c & 31, ob = rr * 64 + cc * 2; return st * 1024 + (ob ^ (((ob >> 9) & 1) << 5)); }
__host__ __device__ __forceinline__ void stage_rc(int b, int& R, int& C) { const int st = b / 1024, sb = b % 1024, swz = sb ^ (((sb >> 9) & 1) << 5); R = (st >> 1) * 16 + swz / 64; C = (st & 1) * 32 + (swz % 64) / 2; }
__host__ __device__ __forceinline__ int perm32(int rho) { const int n = rho >> 4, i = rho & 15; return 8 * (i >> 2) + 4 * n + (i & 3); }

struct Unit { int pm, pn; };
struct Gemm { const bf16_t* A; const bf16_t* Bt; int M, N, K; };

struct StaticOrder {
    int nM, nN, nwg, G, c;
    __host__ __device__ void init(int M, int N, int G_, int c_) { nM = M / BM; nN = N / BM; nwg = nM * nN; G = G_; c = c_; }
    __host__ __device__ bool next(int i, Unit& u) const {
        const long L = (long)i * G + c; if (L >= nwg) return false;
        int wgid = (int)L; { const int q = nwg / NXCD, r = nwg % NXCD, xcd = wgid % NXCD, off = wgid / NXCD; wgid = (xcd < r ? xcd * (q + 1) : r * (q + 1) + (xcd - r) * q) + off; }
        const int nig = WGM * nN, gid = wgid / nig, fm = gid * WGM, gsz = (nM - fm) < WGM ? (nM - fm) : WGM;
        u.pm = fm + ((wgid % nig) % gsz); u.pn = (wgid % nig) / gsz; return true;
    }
    __device__ __forceinline__ void a_ready(const Unit&) const {}
    __device__ __forceinline__ void done(const Unit&) const {}
};

template <class Epi, class Sched, bool ALIGN_EPI = false, bool SP2 = false>
__device__ __forceinline__ void gemm_phase(PG8_LAS unsigned char* lds, const Gemm g, const Sched& S, const Epi& E) {
    int tid = threadIdx.x; asm volatile("" : "+v"(tid)); const int wid = __builtin_amdgcn_readfirstlane(tid >> 6), lane = tid & 63, wr = wid >> 2, wc = wid & 3, fr = lane & 15, fq = lane >> 4;
    const int K = g.K, nt = K / BK;
    unsigned voffA[2], voffB[2];
#pragma unroll
    for (int i = 0; i < 2; ++i) { int R, C; stage_rc(tid * 16 + i * 8192, R, C); const int Rb = Epi::PERM ? ((R & ~31) + perm32(R & 31)) : R;
        voffA[i] = (unsigned)(R * K + C) * 2u; voffB[i] = (unsigned)(Rb * K + C) * 2u; }
    const size_t kstep = (size_t)(BK * 2);
    const size_t hstep = (size_t)HALF * K * 2;
    const size_t tstep = 2 * hstep;
    const unsigned ldsw = (unsigned)wid * 1024u;
    const int aoff = lds_byte(wr * 64 + fr, fq * 8), boff = lds_byte(wc * 32 + fr, fq * 8);
#define PG8_SA(b, h) (((b) * 2 + (h)) * HTB)
#define PG8_SB(b, h) ((4 + (b) * 2 + (h)) * HTB)
#define PG8_STAGE(bufoff, gbase, voff) do { _Pragma("unroll") for (int _i = 0; _i < 2; ++_i) \
        __builtin_amdgcn_global_load_lds((const unsigned*)((const char*)(gbase) + (voff)[_i]), (PG8_LAS unsigned*)(lds + (bufoff) + ldsw + _i * 8192), 16, 0, 0); } while (0)
#define PG8_LDA(dst, b, h) do { _Pragma("unroll") for (int m = 0; m < 4; ++m) _Pragma("unroll") for (int k = 0; k < 2; ++k) dst[m][k] = *(const PG8_LAS bf16x8*)(lds + PG8_SA(b, h) + aoff + m * 2048 + k * 1024); } while (0)
#define PG8_LDB(dst, b, h) do { _Pragma("unroll") for (int n = 0; n < 2; ++n) _Pragma("unroll") for (int k = 0; k < 2; ++k) dst[n][k] = *(const PG8_LAS bf16x8*)(lds + PG8_SB(b, h) + boff + n * 2048 + k * 1024); } while (0)
#define PG8_MMA(ai, bj, At, Bt) do { __builtin_amdgcn_s_setprio(1); _Pragma("unroll") for (int m = 0; m < 4; ++m) _Pragma("unroll") for (int n = 0; n < 2; ++n) _Pragma("unroll") for (int k = 0; k < 2; ++k) \
        acc[ai][bj][m][n] = __builtin_amdgcn_mfma_f32_16x16x32_bf16(Bt[n][k], At[m][k], acc[ai][bj][m][n], 0, 0, 0); __builtin_amdgcn_s_setprio(0); } while (0)
#define PG8_WAIT_V(n) asm volatile("s_waitcnt vmcnt(" #n ")" ::: "memory")
#define PG8_WAIT_L(n) asm volatile("s_waitcnt lgkmcnt(" #n ")" ::: "memory")
#define PG8_BAR __builtin_amdgcn_s_barrier()
#define PG8_SCHED __builtin_amdgcn_sched_barrier(0)
    Unit cur, nxt; int ui = 0;
    if (!S.next(0, cur)) return;
    f32x4 acc[2][2][4][2];
#pragma unroll
    for (int a = 0; a < 2; ++a)
#pragma unroll
        for (int b = 0; b < 2; ++b)
#pragma unroll
            for (int m = 0; m < 4; ++m)
#pragma unroll
                for (int n = 0; n < 2; ++n) acc[a][b][m][n] = (f32x4){0.f, 0.f, 0.f, 0.f};
    bf16x8 At[4][2], B0[2][2], B1[2][2];
    const char* cA = (const char*)g.A + (size_t)cur.pm * tstep; const char* cB = (const char*)g.Bt + (size_t)cur.pn * tstep;
    S.a_ready(cur);
    if constexpr (SP2) {
        PG8_STAGE(PG8_SB(0, 0), cB, voffB); PG8_STAGE(PG8_SB(0, 1), cB + hstep, voffB); PG8_STAGE(PG8_SA(0, 0), cA, voffA); PG8_STAGE(PG8_SA(0, 1), cA + hstep, voffA);
        if (wr == 1) PG8_BAR;
        PG8_WAIT_V(2); PG8_BAR;
        PG8_STAGE(PG8_SB(1, 0), cB + kstep, voffB); PG8_STAGE(PG8_SA(1, 0), cA + kstep, voffA); PG8_STAGE(PG8_SB(1, 1), cB + hstep + kstep, voffB);
        PG8_WAIT_V(6); PG8_BAR;
    } else {
        PG8_STAGE(PG8_SB(0, 0), cB, voffB); PG8_STAGE(PG8_SA(0, 0), cA, voffA); PG8_STAGE(PG8_SB(0, 1), cB + hstep, voffB); PG8_STAGE(PG8_SA(0, 1), cA + hstep, voffA);
        if (wr == 1) PG8_BAR;
        PG8_WAIT_V(4); PG8_BAR;
        PG8_STAGE(PG8_SB(1, 0), cB + kstep, voffB); PG8_STAGE(PG8_SA(1, 0), cA + kstep, voffA); PG8_STAGE(PG8_SB(1, 1), cB + hstep + kstep, voffB);
        PG8_WAIT_V(6); PG8_BAR;
    }
    for (;;) {
        const bool has_next = S.next(ui + 1, nxt);
        const char* nA = has_next ? (const char*)g.A + (size_t)nxt.pm * tstep : cA; const char* nB = has_next ? (const char*)g.Bt + (size_t)nxt.pn * tstep : cB;
        for (int t = 0; t < nt; t += 2) {
            const bool last = (t == nt - 2);
            const char* a1 = cA + (size_t)(t + 1) * kstep;
            const char* a2 = last ? nA : cA + (size_t)(t + 2) * kstep; const char* b2 = last ? nB : cB + (size_t)(t + 2) * kstep;
            const char* a3 = a2 + kstep; const char* b3 = b2 + kstep;
            if (last && has_next) S.a_ready(nxt);
            if constexpr (SP2) {
            PG8_LDB(B0, 0, 0); PG8_LDB(B1, 0, 1); PG8_SCHED; PG8_LDA(At, 0, 0); PG8_STAGE(PG8_SA(1, 1), a1 + hstep, voffA);
            PG8_WAIT_V(8); PG8_WAIT_L(0); PG8_BAR; PG8_MMA(0, 0, At, B0); PG8_MMA(0, 1, At, B1); PG8_BAR; PG8_SCHED;
            PG8_LDA(At, 0, 1); PG8_STAGE(PG8_SB(0, 0), b2, voffB); PG8_STAGE(PG8_SB(0, 1), b2 + hstep, voffB); PG8_STAGE(PG8_SA(0, 0), a2, voffA);
            PG8_WAIT_V(8); PG8_WAIT_L(0); PG8_BAR; PG8_MMA(1, 0, At, B0); PG8_MMA(1, 1, At, B1); PG8_BAR; PG8_SCHED;
            PG8_LDB(B0, 1, 0); PG8_LDB(B1, 1, 1); PG8_SCHED; PG8_LDA(At, 1, 0); PG8_STAGE(PG8_SA(0, 1), a2 + hstep, voffA);
            PG8_WAIT_V(8); PG8_WAIT_L(0); PG8_BAR; PG8_MMA(0, 0, At, B0); PG8_MMA(0, 1, At, B1); PG8_BAR; PG8_SCHED;
            PG8_LDA(At, 1, 1); PG8_STAGE(PG8_SB(1, 0), b3, voffB); PG8_STAGE(PG8_SB(1, 1), b3 + hstep, voffB); PG8_STAGE(PG8_SA(1, 0), a3, voffA);
            PG8_WAIT_V(8); PG8_WAIT_L(0); PG8_BAR; PG8_MMA(1, 0, At, B0); PG8_MMA(1, 1, At, B1); PG8_BAR; PG8_SCHED;
            } else {
            PG8_LDB(B0, 0, 0); PG8_SCHED; PG8_LDA(At, 0, 0); PG8_STAGE(PG8_SA(1, 1), a1 + hstep, voffA);
            PG8_WAIT_L(8); PG8_BAR; PG8_WAIT_L(0); PG8_MMA(0, 0, At, B0); PG8_BAR; PG8_SCHED;
            PG8_LDB(B1, 0, 1); PG8_STAGE(PG8_SB(0, 0), b2, voffB);
            PG8_BAR; PG8_WAIT_L(0); PG8_MMA(0, 1, At, B1); PG8_BAR;
            PG8_LDA(At, 0, 1); PG8_STAGE(PG8_SA(0, 0), a2, voffA);
            PG8_BAR; PG8_WAIT_L(0); PG8_MMA(1, 0, At, B0); PG8_BAR; PG8_SCHED;
            PG8_STAGE(PG8_SB(0, 1), b2 + hstep, voffB);
            PG8_WAIT_V(6); PG8_BAR; PG8_MMA(1, 1, At, B1); PG8_BAR;
            PG8_LDB(B0, 1, 0); PG8_SCHED; PG8_LDA(At, 1, 0); PG8_STAGE(PG8_SA(0, 1), a2 + hstep, voffA);
            PG8_WAIT_L(8); PG8_BAR; PG8_WAIT_L(0); PG8_MMA(0, 0, At, B0); PG8_BAR; PG8_SCHED;
            PG8_LDB(B1, 1, 1); PG8_STAGE(PG8_SB(1, 0), b3, voffB);
            PG8_BAR; PG8_WAIT_L(0); PG8_MMA(0, 1, At, B1); PG8_BAR;
            PG8_LDA(At, 1, 1); PG8_STAGE(PG8_SA(1, 0), a3, voffA);
            PG8_BAR; PG8_WAIT_L(0); PG8_MMA(1, 0, At, B0); PG8_BAR; PG8_SCHED;
            PG8_STAGE(PG8_SB(1, 1), b3 + hstep, voffB);
            PG8_WAIT_V(6); PG8_BAR; PG8_MMA(1, 1, At, B1); PG8_BAR;
            }
        }
        if constexpr (ALIGN_EPI) { if (wr == 0) PG8_BAR; }
        if constexpr (!Epi::AFTER_DRAIN) { E(acc, cur, wr, wc, fr, fq); S.done(cur); }
        if (!has_next) break;
#pragma unroll
        for (int a = 0; a < 2; ++a)
#pragma unroll
            for (int b = 0; b < 2; ++b)
#pragma unroll
                for (int m = 0; m < 4; ++m)
#pragma unroll
                    for (int n = 0; n < 2; ++n) acc[a][b][m][n] = (f32x4){0.f, 0.f, 0.f, 0.f};
        cur = nxt; cA = nA; cB = nB; ++ui;
        if constexpr (ALIGN_EPI) { if (wr == 1) PG8_BAR; }
    }
    PG8_WAIT_V(0);
    if constexpr (!ALIGN_EPI) { if (wr == 0) PG8_BAR; }
    PG8_BAR;
    if constexpr (Epi::AFTER_DRAIN) { E.fused(acc, cur, wr, wc, fr, fq, lds, wid, lane); S.done(cur); }
#undef PG8_SA
#undef PG8_SB
#undef PG8_STAGE
#undef PG8_LDA
#undef PG8_LDB
#undef PG8_MMA
#undef PG8_WAIT_V
#undef PG8_WAIT_L
#undef PG8_BAR
#undef PG8_SCHED
}
}

#define DI __device__ __forceinline__
#define LAS __attribute__((address_space(3)))
using pg8::bf16_t; using pg8::bf16x8; using pg8::f32x4; using pg8::u32x4; using pg8::Unit;
typedef unsigned u32x2 __attribute__((ext_vector_type(2)));
typedef float f32x2 __attribute__((ext_vector_type(2)));
typedef __bf16 bf16x2_t __attribute__((ext_vector_type(2)));

constexpr int DM = 1024, BATCH = 8, SEQ = 2048, MTOK = BATCH * SEQ, NMEMT = 256, MMEM = BATCH * NMEMT;
constexpr int DFF = 2816, NGU = 2 * DFF, NINA = 3328, NINB = 1792, NKV = 1792, KVSRC = 1548, NMKV = 2048;
constexpr float EPS = 1e-6f, LOG2E = 1.4426950408889634f, QSCALE = 0.125f * 1.4426950408889634f;
constexpr int NTHREADS = 512, LDS_BYTES = 147456, XCD_BAR_WORDS_C = 3456, LDS_BARST = LDS_BYTES - 64;

constexpr size_t SZ_WGU = (size_t)NGU * DM * 2, SZ_WD = (size_t)DM * DFF * 2, SZ_WINA = (size_t)NINA * DM * 2, SZ_WINB = (size_t)NINB * DM * 2,
                 SZ_WKV = (size_t)NKV * DM * 2, SZ_WOUT = (size_t)DM * DM * 2, SZ_WMKV = (size_t)NMKV * DM * 2;
constexpr size_t O_WGU1 = 0, O_WD1 = O_WGU1 + 4 * SZ_WGU, O_WGU2 = O_WD1 + 4 * SZ_WD, O_WD2 = O_WGU2 + 4 * SZ_WGU, O_WINA = O_WD2 + 4 * SZ_WD,
                 O_WINB = O_WINA + 2 * SZ_WINA, O_WKV = O_WINB + 2 * SZ_WINB, O_WOUT = O_WKV + SZ_WKV, O_WMKV = O_WOUT + 4 * SZ_WOUT,
                 O_XB = O_WMKV + SZ_WMKV, O_U = O_XB + (size_t)MTOK * DM * 2;
constexpr size_t O_ACT = O_U, O_QB = O_U, O_LF = O_QB + (size_t)MTOK * 768 * 2, O_VB = O_LF + (size_t)MTOK * 768 * 4, O_MIX = O_VB + (size_t)MTOK * 768 * 2;
constexpr size_t SZ_U = (size_t)MTOK * 768 * 8 + (size_t)MTOK * 1024 * 2;
static_assert(SZ_U >= (size_t)MTOK * DFF * 2, "U region holds ACT");
constexpr size_t O_KSH = O_U + SZ_U, O_VSH = O_KSH + (size_t)MTOK * 768 * 2, O_LFX = O_VSH + (size_t)MTOK * 768 * 2, O_DL = O_LFX + 96 * 2048 * 4,
                 O_MEMB = O_DL + 96 * 2048 * 4, O_MK = O_MEMB + (size_t)MMEM * DM * 2, O_MV = O_MK + 4 * (size_t)MMEM * 256 * 2,
                 O_SSQ = O_MV + 4 * (size_t)MMEM * 256 * 2, O_SSQM = O_SSQ + 16 * (size_t)MTOK * 4, O_LBV = O_SSQM + (size_t)MMEM * 4, O_BAR = O_LBV + 2 * 768 * 4, WS_END = O_BAR + XCD_BAR_WORDS_C * 4;

struct Params { const float* in[25]; float* out; unsigned char* ws; };

DI unsigned pk2(float lo, float hi) { f32x2 v = {lo, hi}; bf16x2_t b = __builtin_convertvector(v, bf16x2_t); return __builtin_bit_cast(unsigned, b); }
typedef _Float16 half2_t __attribute__((ext_vector_type(2)));
DI unsigned pkh(float lo, float hi) { f32x2 v = {lo, hi}; half2_t h = __builtin_convertvector(v, half2_t); return __builtin_bit_cast(unsigned, h); }
DI float hlo(unsigned u) { const half2_t h = __builtin_bit_cast(half2_t, u); return (float)h[0]; }
DI float hhi(unsigned u) { const half2_t h = __builtin_bit_cast(half2_t, u); return (float)h[1]; }
DI u32x4 pack8h(f32x4 a, f32x4 b) { u32x4 w; w.x = pkh(a[0], a[1]); w.y = pkh(a[2], a[3]); w.z = pkh(b[0], b[1]); w.w = pkh(b[2], b[3]); return w; }
DI float bflo(unsigned u) { return __uint_as_float(u << 16); }
DI float bfhi(unsigned u) { return __uint_as_float(u & 0xffff0000u); }
DI float bf1(bf16_t h) { return __uint_as_float((unsigned)h << 16); }
DI u32x4 pack8(f32x4 a, f32x4 b) { u32x4 w; w.x = pk2(a[0], a[1]); w.y = pk2(a[2], a[3]); w.z = pk2(b[0], b[1]); w.w = pk2(b[2], b[3]); return w; }
DI float silu_f(float x) { return x * __builtin_amdgcn_rcpf(1.f + __expf(-x)); }
DI float sigm_f(float x) { return __builtin_amdgcn_rcpf(1.f + __expf(-x)); }
DI float logsig_f(float z) { return fminf(z, 0.f) - __logf(1.f + __expf(-fabsf(z))); }
DI float wave_sum(float v) {
#pragma unroll
    for (int o = 1; o < 64; o <<= 1) v += __shfl_xor(v, o);
    return v;
}
DI float row_rstd(const float* ssq, int row, int fq) {
    const f32x4 a = *(const f32x4*)(ssq + (size_t)row * 16 + 4 * fq); float t = (a[0] + a[1]) + (a[2] + a[3]);
    t += __shfl_xor(t, 16); t += __shfl_xor(t, 32); return rsqrtf(t * (1.f / DM) + EPS); }
#define MFMA16(a, b, c) __builtin_amdgcn_mfma_f32_16x16x32_bf16((a), (b), (c), 0, 0, 0)

#define EPI_ROW_RSTD(ssq_) float rs[2][4]; \
    _Pragma("unroll") for (int ai = 0; ai < 2; ++ai) _Pragma("unroll") for (int m = 0; m < 4; ++m) rs[ai][m] = row_rstd(ssq_, row0 + ai * 128 + m * 16, fq);
struct EpiGateUp {
    static constexpr bool PERM = true, AFTER_DRAIN = false;
    bf16_t* O; const float* ssq;
    DI void operator()(f32x4 (&acc)[2][2][4][2], const Unit& u, int wr, int wc, int fr, int fq) const {
        const int row0 = u.pm * 256 + wr * 64 + fr, col0 = u.pn * 128 + wc * 32 + 8 * fq;
        EPI_ROW_RSTD(ssq)
#pragma unroll
        for (int ai = 0; ai < 2; ++ai)
#pragma unroll
            for (int m = 0; m < 4; ++m) {
                const int row = row0 + ai * 128 + m * 16; const float r1 = rs[ai][m];
                f32x4 o[2];
#pragma unroll
                for (int n = 0; n < 2; ++n) {
                    const f32x4 g = acc[ai][0][m][n] * r1, v = acc[ai][1][m][n] * r1;
#pragma unroll
                    for (int e = 0; e < 4; ++e) o[n][e] = silu_f(g[e]) * v[e];
                }
                *(u32x4*)(O + (size_t)row * DFF + col0) = pack8(o[0], o[1]);
            }
    }
};
struct EpiResid {
    static constexpr bool PERM = true, AFTER_DRAIN = false;
    const float* xin32; bf16_t* xb; float* xout32; float* ssq_out; float scale;
    DI void operator()(f32x4 (&acc)[2][2][4][2], const Unit& u, int wr, int wc, int fr, int fq) const {
        const int row0 = u.pm * 256 + wr * 64 + fr, col0 = u.pn * 256 + wc * 32 + 8 * fq;
        u32x4 cur[2], nxt[2];
        if (!xin32) {
#pragma unroll
            for (int bj = 0; bj < 2; ++bj) cur[bj] = *(const u32x4*)(xb + (size_t)row0 * DM + col0 + bj * 128);
        }
#pragma unroll
        for (int r = 0; r < 8; ++r) {
            const int ai = r >> 2, m = r & 3; const int row = row0 + ai * 128 + m * 16;
            f32x4 xo[2][2];
            if (xin32) {
#pragma unroll
                for (int bj = 0; bj < 2; ++bj) { const size_t off = (size_t)row * DM + col0 + bj * 128; xo[bj][0] = *(const f32x4*)(xin32 + off); xo[bj][1] = *(const f32x4*)(xin32 + off + 4); }
            } else {
                if (r < 7) { const int rown = row0 + ((r + 1) >> 2) * 128 + ((r + 1) & 3) * 16;
#pragma unroll
                    for (int bj = 0; bj < 2; ++bj) nxt[bj] = *(const u32x4*)(xb + (size_t)rown * DM + col0 + bj * 128); }
#pragma unroll
                for (int bj = 0; bj < 2; ++bj) { const u32x4 c = cur[bj];
                    xo[bj][0] = (f32x4){bflo(c.x), bfhi(c.x), bflo(c.y), bfhi(c.y)}; xo[bj][1] = (f32x4){bflo(c.z), bfhi(c.z), bflo(c.w), bfhi(c.w)}; }
            }
            float ss = 0.f;
#pragma unroll
            for (int bj = 0; bj < 2; ++bj) {
                const size_t off = (size_t)row * DM + col0 + bj * 128;
                const f32x4 a = xo[bj][0] + acc[ai][bj][m][0] * scale, b = xo[bj][1] + acc[ai][bj][m][1] * scale;
                *(u32x4*)(xb + off) = pack8(a, b);
                if (xout32) { *(f32x4*)(xout32 + off) = a; *(f32x4*)(xout32 + off + 4) = b; }
                ss += (a[0] * a[0] + a[1] * a[1]) + (a[2] * a[2] + a[3] * a[3]) + (b[0] * b[0] + b[1] * b[1]) + (b[2] * b[2] + b[3] * b[3]);
            }
            ss += __shfl_xor(ss, 16); ss += __shfl_xor(ss, 32);
            if (fq == 0) ssq_out[(size_t)row * 16 + u.pn * 4 + wc] = ss;
            if (!xin32 && r < 7) { cur[0] = nxt[0]; cur[1] = nxt[1]; }
        }
    }
};
DI void headnorm_store(const f32x4 (&z)[2][2], const f32x4 (&g)[2][2], float post, bf16_t* dst, int fq) {
    float ss = 0.f;
#pragma unroll
    for (int bj = 0; bj < 2; ++bj)
#pragma unroll
        for (int n = 0; n < 2; ++n) { const f32x4 t = z[bj][n]; ss += (t[0] * t[0] + t[1] * t[1]) + (t[2] * t[2] + t[3] * t[3]); }
    ss += __shfl_xor(ss, 16); ss += __shfl_xor(ss, 32);
    const float rn = rsqrtf(ss * (1.f / 64.f) + EPS) * post;
#pragma unroll
    for (int bj = 0; bj < 2; ++bj) *(u32x4*)(dst + 32 * bj + 8 * fq) = pack8(z[bj][0] * rn * g[bj][0], z[bj][1] * rn * g[bj][1]);
}
#define EPI_LOAD_GAIN(gv_, gain_) f32x4 gv_[2][2]; \
    _Pragma("unroll") for (int bj = 0; bj < 2; ++bj) { gv_[bj][0] = *(const f32x4*)((gain_) + 32 * bj + 8 * fq); gv_[bj][1] = *(const f32x4*)((gain_) + 32 * bj + 8 * fq + 4); }
#define EPI_Z() asm volatile("" ::: "memory"); f32x4 z[2][2]; \
    _Pragma("unroll") for (int bj = 0; bj < 2; ++bj) _Pragma("unroll") for (int n = 0; n < 2; ++n) z[bj][n] = acc[ai][bj][m][n] * rs[ai][m];
struct EpiInA {
    static constexpr bool PERM = true, AFTER_DRAIN = false;
    const float* ssq; bf16_t* QB; bf16_t* LF  ; bf16_t* VB; bf16_t* MIX; const float* lb; const float* mqgain; int pn_off; int lbzero = 0;
    DI void operator()(f32x4 (&acc)[2][2][4][2], const Unit& u, int wr, int wc, int fr, int fq) const {
        const int t = u.pn + pn_off, row0 = u.pm * 256 + wr * 64 + fr, c8 = wc * 32 + 8 * fq;
        EPI_ROW_RSTD(ssq)
        EPI_LOAD_GAIN(gv, mqgain)
#pragma unroll
        for (int ai = 0; ai < 2; ++ai)
#pragma unroll
            for (int m = 0; m < 4; ++m) {
                const int row = row0 + ai * 128 + m * 16; EPI_Z()
                if (t < 3) {
#pragma unroll
                    for (int bj = 0; bj < 2; ++bj) { f32x4 a = z[bj][0], b = z[bj][1];
#pragma unroll
                        for (int e = 0; e < 4; ++e) { a[e] = silu_f(a[e]); b[e] = silu_f(b[e]); }
                        *(u32x4*)(QB + (size_t)row * 768 + t * 256 + bj * 128 + c8) = pack8(a, b); }
                } else if (t < 6) {
#pragma unroll
                    for (int bj = 0; bj < 2; ++bj) { const int col = (t - 3) * 256 + bj * 128 + c8;
                        const f32x4 l0 = *(const f32x4*)(lb + col), l1 = *(const f32x4*)(lb + col + 4); f32x4 a, b;
#pragma unroll
                        for (int e = 0; e < 4; ++e) {
                            const float la = logsig_f(z[bj][0][e]), lc = logsig_f(z[bj][1][e]);
                            if (lbzero) { a[e] = la; b[e] = lc; }
                            else { a[e] = (l0[e] == 0.f) ? la : __logf(l0[e] + (1.f - l0[e]) * __expf(la));
                                   b[e] = (l1[e] == 0.f) ? lc : __logf(l1[e] + (1.f - l1[e]) * __expf(lc)); }
                        }
                        *(u32x4*)(LF + (size_t)row * 768 + col) = pack8h(a, b); }
                } else if (t < 9) {
#pragma unroll
                    for (int bj = 0; bj < 2; ++bj) *(u32x4*)(VB + (size_t)row * 768 + (t - 6) * 256 + bj * 128 + c8) = pack8(z[bj][0], z[bj][1]);
                } else if (t < 12) {
#pragma unroll
                    for (int bj = 0; bj < 2; ++bj) { f32x4 a = z[bj][0], b = z[bj][1];
#pragma unroll
                        for (int e = 0; e < 4; ++e) { a[e] = silu_f(a[e]); b[e] = silu_f(b[e]); }
                        *(u32x4*)(MIX + (size_t)row * 1024 + (t - 9) * 256 + bj * 128 + c8) = pack8(a, b); }
                } else {
                    headnorm_store(z, gv, QSCALE, MIX + (size_t)row * 1024 + 768 + 64 * wc, fq);
                }
            }
    }
};
struct EpiInB {
    static constexpr bool PERM = true, AFTER_DRAIN = false;
    const float* ssq; bf16_t* QB; bf16_t* MIX; const float* fqgain; const float* mqgain;
    DI void operator()(f32x4 (&acc)[2][2][4][2], const Unit& u, int wr, int wc, int fr, int fq) const {
        const int t = u.pn, row0 = u.pm * 256 + wr * 64 + fr, c8 = wc * 32 + 8 * fq;
        EPI_ROW_RSTD(ssq)
        if (t < 3 || t == 6) {
            EPI_LOAD_GAIN(gv, (t < 3) ? fqgain : mqgain)
#pragma unroll
            for (int ai = 0; ai < 2; ++ai)
#pragma unroll
                for (int m = 0; m < 4; ++m) { const int row = row0 + ai * 128 + m * 16; EPI_Z()
                    headnorm_store(z, gv, QSCALE, (t < 3) ? QB + (size_t)row * 768 + t * 256 + 64 * wc : MIX + (size_t)row * 1024 + 768 + 64 * wc, fq); }
        } else {
#pragma unroll
            for (int ai = 0; ai < 2; ++ai)
#pragma unroll
                for (int m = 0; m < 4; ++m) { const int row = row0 + ai * 128 + m * 16; EPI_Z()
#pragma unroll
                    for (int bj = 0; bj < 2; ++bj) { f32x4 a = z[bj][0], b = z[bj][1];
#pragma unroll
                        for (int e = 0; e < 4; ++e) { a[e] = sigm_f(a[e]); b[e] = sigm_f(b[e]); }
                        *(u32x4*)(MIX + (size_t)row * 1024 + (t - 3) * 256 + bj * 128 + c8) = pack8(a, b); } }
        }
    }
};
struct EpiKV {
    static constexpr bool PERM = true, AFTER_DRAIN = false;
    const float* ssq; bf16_t* KSH; bf16_t* VSH; float* LFX; const float* kgain; const float* fbias;
    DI void operator()(f32x4 (&acc)[2][2][4][2], const Unit& u, int wr, int wc, int fr, int fq) const {
        const int t = u.pn, row0 = u.pm * 256 + wr * 64 + fr, c8 = wc * 32 + 8 * fq;
        EPI_ROW_RSTD(ssq)
        if (t < 3) {
            EPI_LOAD_GAIN(gv, kgain)
#pragma unroll
            for (int ai = 0; ai < 2; ++ai)
#pragma unroll
                for (int m = 0; m < 4; ++m) { const int row = row0 + ai * 128 + m * 16; EPI_Z()
                    headnorm_store(z, gv, 1.0f, KSH + (size_t)row * 768 + t * 256 + 64 * wc, fq); }
        } else if (t < 6) {
#pragma unroll
            for (int ai = 0; ai < 2; ++ai)
#pragma unroll
                for (int m = 0; m < 4; ++m) { const int row = row0 + ai * 128 + m * 16; EPI_Z()
#pragma unroll
                    for (int bj = 0; bj < 2; ++bj) *(u32x4*)(VSH + (size_t)row * 768 + (t - 3) * 256 + bj * 128 + c8) = pack8(z[bj][0], z[bj][1]); }
        } else if (wc == 0 && fq < 2) {
            float fb[2][4];
#pragma unroll
            for (int n = 0; n < 2; ++n)
#pragma unroll
                for (int e = 0; e < 4; ++e) { const int hh = 8 * fq + 4 * n + e; fb[n][e] = (hh < 12) ? fbias[hh] : 0.f; }
#pragma unroll
            for (int ai = 0; ai < 2; ++ai)
#pragma unroll
                for (int m = 0; m < 4; ++m) { const int row = row0 + ai * 128 + m * 16; EPI_Z()
                    const int b = row >> 11, sq = row & 2047;
#pragma unroll
                    for (int n = 0; n < 2; ++n)
#pragma unroll
                        for (int e = 0; e < 4; ++e) { const int hh = 8 * fq + 4 * n + e;
                            if (hh < 12) LFX[(size_t)(b * 12 + hh) * 2048 + sq] = logsig_f(z[0][n][e] + fb[n][e]); } }
        }
    }
};
struct EpiMemKV {
    static constexpr bool PERM = true, AFTER_DRAIN = false;
    const float* ssqm; bf16_t* MK; bf16_t* MV; const float* kgain_all;
    DI void operator()(f32x4 (&acc)[2][2][4][2], const Unit& u, int wr, int wc, int fr, int fq) const {
        const int l = u.pn >> 1, isv = u.pn & 1, row0 = u.pm * 256 + wr * 64 + fr, c8 = wc * 32 + 8 * fq;
        float rs[2][4];
#pragma unroll
        for (int ai = 0; ai < 2; ++ai)
#pragma unroll
            for (int m = 0; m < 4; ++m) rs[ai][m] = rsqrtf(ssqm[row0 + ai * 128 + m * 16] * (1.f / DM) + EPS);
        EPI_LOAD_GAIN(gv, kgain_all + 64 * l)
#pragma unroll
        for (int ai = 0; ai < 2; ++ai)
#pragma unroll
            for (int m = 0; m < 4; ++m) { const int row = row0 + ai * 128 + m * 16; EPI_Z()
                if (!isv) headnorm_store(z, gv, 1.0f, MK + ((size_t)l * MMEM + row) * 256 + 64 * wc, fq);
                else {
#pragma unroll
                    for (int bj = 0; bj < 2; ++bj) *(u32x4*)(MV + ((size_t)l * MMEM + row) * 256 + bj * 128 + c8) = pack8(z[bj][0], z[bj][1]); } }
    }
};

struct OneUnit {
    int pm;
    DI bool next(int i, Unit& u) const { if (i) return false; u.pm = pm; u.pn = 0; return true; }
    DI void a_ready(const Unit&) const {}
    DI void done(const Unit&) const {}
};
enum { MODE_NAT = 0, MODE_GU = 1, MODE_INA = 2, MODE_INB = 3, MODE_KV = 4, MODE_MEMKV = 5 };
DI void map_blk(int mode, int blk, int& scol, int& nvalid, int& which) {
    nvalid = 32; which = 0;
    const int tile = blk >> 3, j = blk & 7, pj = 64 * (j & 3) + 32 * (j >> 2);
    switch (mode) {
        case MODE_GU: which = j >> 2; scol = 128 * tile + 32 * (j & 3); break;
        case MODE_INA: scol = (tile == 12) ? 256 * tile + pj : 32 * blk; break;
        case MODE_INB: scol = (tile <= 2 || tile == 6) ? 256 * tile + pj : 32 * blk; break;
        case MODE_KV: if (tile <= 2) scol = 256 * tile + pj; else if (tile <= 5) scol = 32 * blk; else { scol = 1536; nvalid = (j == 0) ? 12 : 0; } break;
        case MODE_MEMKV: scol = (tile == 0) ? pj : 32 * blk; break;
        default: scol = 32 * blk; break;
    }
}
DI void conv_item(const float* W, int ldw, int K, bf16_t* WT, int dst_row0, int src_col0, int nvalid, const float* gain, int k0, LAS float* scr, int lane) {
    if (nvalid == 32) {
        const int kk0 = lane >> 3, n4 = lane & 7;
        f32x4 v[8];
#pragma unroll
        for (int i = 0; i < 8; ++i) v[i] = *(const f32x4*)(W + (size_t)(k0 + kk0 + 8 * i) * ldw + src_col0 + 4 * n4);
#pragma unroll
        for (int i = 0; i < 8; ++i) { LAS float* d = scr + (kk0 + 8 * i) * 33 + 4 * n4; d[0] = v[i][0]; d[1] = v[i][1]; d[2] = v[i][2]; d[3] = v[i][3]; }
    } else {
        const int c = lane & 31;
#pragma unroll 8
        for (int i = 0; i < 32; ++i) { const int kk = 2 * i + (lane >> 5);
            scr[kk * 33 + c] = (c < nvalid) ? W[(size_t)(k0 + kk) * ldw + src_col0 + c] : 0.f; }
    }
    asm volatile("s_waitcnt lgkmcnt(0)" ::: "memory");
    const int c8 = lane & 7;
    f32x4 g0 = (f32x4){1.f, 1.f, 1.f, 1.f}, g1 = g0;
    if (gain) { g0 = *(const f32x4*)(gain + k0 + 8 * c8); g1 = *(const f32x4*)(gain + k0 + 8 * c8 + 4); }
#pragma unroll
    for (int j = 0; j < 4; ++j) { const int n = (lane >> 3) + 8 * j; const LAS float* s = scr + (8 * c8) * 33 + n;
        u32x4 o; o.x = pk2(s[0 * 33] * g0[0], s[1 * 33] * g0[1]); o.y = pk2(s[2 * 33] * g0[2], s[3 * 33] * g0[3]); o.z = pk2(s[4 * 33] * g1[0], s[5 * 33] * g1[1]); o.w = pk2(s[6 * 33] * g1[2], s[7 * 33] * g1[3]);
        *(u32x4*)(WT + (size_t)(dst_row0 + n) * K + k0 + 8 * c8) = o; }
    asm volatile("s_waitcnt lgkmcnt(0)" ::: "memory");
}
DI void conv_job(int mode, const float* src, const float* src2, int ldw, int K, bf16_t* dst, int ndblk, const float* gain, int& base, int gw, int NGW, LAS float* scr, int lane) {
    const int nitems = ndblk * (K / 64);
    int it = gw - (base % NGW); if (it < 0) it += NGW;
    for (; it < nitems; it += NGW) {
        const int kb = it / ndblk, nb = it - kb * ndblk; int scol, nvalid, which;
        map_blk(mode, nb, scol, nvalid, which);
        conv_item(which ? src2 : src, ldw, K, dst, nb * 32, scol, nvalid, gain, kb * 64, scr, lane);
    }
    base += nitems;
}
DI void row_to_bf16(const float* xrow, bf16_t* orow, float* ssq1, int lane, bool slots) {
    const f32x4* xr = (const f32x4*)xrow + lane; f32x4 v[4]; float s = 0.f;
#pragma unroll
    for (int j = 0; j < 4; ++j) { v[j] = xr[64 * j]; s += (v[j][0] * v[j][0] + v[j][1] * v[j][1]) + (v[j][2] * v[j][2] + v[j][3] * v[j][3]); }
    s = wave_sum(s);
    u32x2* o8 = (u32x2*)orow + lane;
#pragma unroll
    for (int j = 0; j < 4; ++j) { u32x2 o; o.x = pk2(v[j][0], v[j][1]); o.y = pk2(v[j][2], v[j][3]); o8[64 * j] = o; }
    if (slots) { if (lane < 16) ssq1[lane] = lane ? 0.f : s; } else if (lane == 0) *ssq1 = s;
}


DI void conv_layer(const Params& p, unsigned char* ws, int l, int& base, int gw, int NGW, LAS float* scr, int lane) {
    conv_job(MODE_GU, p.in[3] + (size_t)l * DM * DFF, p.in[4] + (size_t)l * DM * DFF, DFF, DM, (bf16_t*)(ws + O_WGU1 + l * SZ_WGU), NGU / 32, p.in[2] + l * DM, base, gw, NGW, scr, lane);
    conv_job(MODE_NAT, p.in[5] + (size_t)l * DFF * DM, nullptr, DM, DFF, (bf16_t*)(ws + O_WD1 + l * SZ_WD), DM / 32, nullptr, base, gw, NGW, scr, lane);
    conv_job(MODE_GU, p.in[22] + (size_t)l * DM * DFF, p.in[23] + (size_t)l * DM * DFF, DFF, DM, (bf16_t*)(ws + O_WGU2 + l * SZ_WGU), NGU / 32, p.in[21] + l * DM, base, gw, NGW, scr, lane);
    conv_job(MODE_NAT, p.in[24] + (size_t)l * DFF * DM, nullptr, DM, DFF, (bf16_t*)(ws + O_WD2 + l * SZ_WD), DM / 32, nullptr, base, gw, NGW, scr, lane);
    conv_job(MODE_NAT, p.in[20] + (size_t)l * DM * DM, nullptr, DM, DM, (bf16_t*)(ws + O_WOUT + l * SZ_WOUT), DM / 32, nullptr, base, gw, NGW, scr, lane);
    if (l < 2) conv_job(MODE_INA, p.in[11] + (size_t)l * DM * NINA, nullptr, NINA, DM, (bf16_t*)(ws + O_WINA + l * SZ_WINA), NINA / 32, p.in[6] + l * DM, base, gw, NGW, scr, lane);
    else conv_job(MODE_INB, p.in[14] + (size_t)(l - 2) * DM * NINB, nullptr, NINB, DM, (bf16_t*)(ws + O_WINB + (l - 2) * SZ_WINB), NINB / 32, p.in[6] + l * DM, base, gw, NGW, scr, lane);
}
DI void hgrn_chain(const bf16_t* __restrict__ QB, const bf16_t* __restrict__ LF, const bf16_t* __restrict__ VB, const bf16_t* MIXG, bf16_t* MIX, const float* __restrict__ ogain, int b, int h, LAS unsigned char* lds) {
    int tid = threadIdx.x; asm volatile("" : "+v"(tid)); const int lane = tid & 63, w = __builtin_amdgcn_readfirstlane(tid >> 6), l15 = lane & 15, quad = lane >> 4;
    LAS bf16_t* QM = (LAS bf16_t*)lds; LAS bf16_t* KM = QM + 64 * 136; LAS bf16_t* QC = KM + 64 * 136; LAS bf16_t* KEt = QC + 64 * 136;
    LAS bf16_t* Vt = KEt + 128 * 72; LAS bf16_t* Pm = Vt + 128 * 72; LAS bf16_t* Sb = Pm + 64 * 72;
    LAS float* tot = (LAS float*)(Sb + 128 * 136); LAS float* cend = tot + 1024; LAS float* rss = cend + 128;
    for (int i = tid; i < 128 * 136 / 2; i += NTHREADS) ((LAS unsigned*)Sb)[i] = 0u;
    f32x4 S[8];
#pragma unroll
    for (int i = 0; i < 8; ++i) S[i] = (f32x4){0.f, 0.f, 0.f, 0.f};
    const size_t rowbase = (size_t)b * SEQ; const int hc = h * 128;
    const int tp = tid & 31, dvg = tid >> 5;
    unsigned lfr[8]; unsigned qv[8]; u32x4 vv0, vv1;
#define HG_LOAD(n_) do { const size_t r0_ = rowbase + (size_t)(n_) * 64; \
        _Pragma("unroll") for (int i = 0; i < 8; ++i) { const size_t r_ = r0_ + 8 * w + i; lfr[i] = *(const unsigned*)(LF + r_ * 768 + hc + 2 * lane); qv[i] = *(const unsigned*)(QB + r_ * 768 + hc + 2 * lane); } \
        vv0 = *(const u32x4*)(VB + (r0_ + 2 * tp) * 768 + hc + 8 * dvg); vv1 = *(const u32x4*)(VB + (r0_ + 2 * tp + 1) * 768 + hc + 8 * dvg); } while (0)
    HG_LOAD(0);
    for (int n = 0; n < 32; ++n) {
        const int tt = w >> 1, dh = w & 1;
        const size_t r0 = rowbase + (size_t)n * 64;
        bf16_t gq[4][4];
#pragma unroll
        for (int i = 0; i < 4; ++i)
#pragma unroll
            for (int j = 0; j < 4; ++j) gq[i][j] = MIXG[(r0 + 16 * tt + 4 * quad + j) * 1024 + hc + 64 * dh + 16 * i + l15];
        float cx[8], cy[8]; float sx = 0.f, sy = 0.f; f32x2 lf[8];
#pragma unroll
        for (int i = 0; i < 8; ++i) lf[i] = (f32x2){hlo(lfr[i]), hhi(lfr[i])};
#pragma unroll
        for (int i = 0; i < 8; ++i) { sx += lf[i].x; sy += lf[i].y; cx[i] = sx; cy[i] = sy; }
        *(LAS f32x2*)(tot + w * 128 + 2 * lane) = (f32x2){sx, sy};
        __syncthreads();
        float bx = 0.f, by = 0.f, mx = 0.f, my = 0.f, ex = 0.f, ey = 0.f;
#pragma unroll
        for (int g = 0; g < 8; ++g) { const f32x2 t2 = *(const LAS f32x2*)(tot + g * 128 + 2 * lane);
            if (g < w) { bx += t2.x; by += t2.y; } if (g < 4) { mx += t2.x; my += t2.y; } ex += t2.x; ey += t2.y; }
        if (w == 0) *(LAS f32x2*)(cend + 2 * lane) = (f32x2){ex, ey};
        float kex[8], key[8];
        const float emX = __expf(mx), emY = __expf(my), eeX = __expf(ex - mx), eeY = __expf(ey - my);
#pragma unroll
        for (int i = 0; i < 8; ++i) {
            const float cX = bx + cx[i], cY = by + cy[i];
            const float kX = 1.f - __expf(lf[i].x), kY = 1.f - __expf(lf[i].y);
            const float qX = bflo(qv[i]), qY = bfhi(qv[i]);
            const float dX = fminf(fmaxf(cX - mx, -80.f), 80.f), dY = fminf(fmaxf(cY - my, -80.f), 80.f);
            const int t = 8 * w + i;
            const float e1X = __expf(dX), e1Y = __expf(dY), e2X = __builtin_amdgcn_rcpf(e1X), e2Y = __builtin_amdgcn_rcpf(e1Y);
            const float qmX = qX * e1X, qmY = qY * e1Y, kmX = kX * e2X, kmY = kY * e2Y;
            *(LAS unsigned*)(QM + t * 136 + 2 * lane) = pk2(qmX, qmY);
            *(LAS unsigned*)(KM + t * 136 + 2 * lane) = pk2(kmX, kmY);
            *(LAS unsigned*)(QC + t * 136 + 2 * lane) = pk2(qmX * emX, qmY * emY);
            kex[i] = kmX * eeX; key[i] = kmY * eeY;
        }
        { u32x4 a, c2; a.x = pk2(kex[0], kex[1]); a.y = pk2(kex[2], kex[3]); a.z = pk2(kex[4], kex[5]); a.w = pk2(kex[6], kex[7]);
          c2.x = pk2(key[0], key[1]); c2.y = pk2(key[2], key[3]); c2.z = pk2(key[4], key[5]); c2.w = pk2(key[6], key[7]);
          *(LAS u32x4*)(KEt + (2 * lane) * 72 + 8 * w) = a; *(LAS u32x4*)(KEt + (2 * lane + 1) * 72 + 8 * w) = c2; }
#pragma unroll
        for (int i = 0; i < 8; ++i) { const unsigned a = vv0[i >> 1], c2 = vv1[i >> 1];
            const unsigned lo = (i & 1) ? (a >> 16) : (a & 0xffffu), hi = (i & 1) ? (c2 >> 16) : (c2 & 0xffffu);
            *(LAS unsigned*)(Vt + (8 * dvg + i) * 72 + 2 * tp) = lo | (hi << 16); }
        if (n + 1 < 32) HG_LOAD(n + 1);
        __syncthreads();
#pragma unroll
        for (int q = 0; q < 2; ++q) { const int idx = 2 * w + q, si = idx >> 2, ti = idx & 3;
            f32x4 a4 = (f32x4){0.f, 0.f, 0.f, 0.f};
            if (si <= ti) {
                bf16x8 ca[4], cb[4];
#pragma unroll
                for (int ks = 0; ks < 4; ++ks) { ca[ks] = *(const LAS bf16x8*)(KM + (16 * si + l15) * 136 + 32 * ks + 8 * quad); cb[ks] = *(const LAS bf16x8*)(QM + (16 * ti + l15) * 136 + 32 * ks + 8 * quad); }
__builtin_amdgcn_sched_barrier(0);
#pragma unroll
                for (int ks = 0; ks < 4; ++ks) a4 = MFMA16(ca[ks], cb[ks], a4);
                if (si == ti) {
#pragma unroll
                    for (int j = 0; j < 4; ++j) if (4 * quad + j > l15) a4[j] = 0.f; }
            }
            u32x2 pw; pw.x = pk2(a4[0], a4[1]); pw.y = pk2(a4[2], a4[3]);
            *(LAS u32x2*)(Pm + (16 * ti + l15) * 72 + 16 * si + 4 * quad) = pw; }
        __syncthreads();
        f32x4 o[4];
        { bf16x8 ap[2], aq[4];
#pragma unroll
          for (int ks = 0; ks < 2; ++ks) ap[ks] = *(const LAS bf16x8*)(Pm + (16 * tt + l15) * 72 + 32 * ks + 8 * quad);
#pragma unroll
          for (int ks = 0; ks < 4; ++ks) aq[ks] = *(const LAS bf16x8*)(QC + (16 * tt + l15) * 136 + 32 * ks + 8 * quad);
          bf16x8 bv[4][2], bs[4][4];
#pragma unroll
          for (int i = 0; i < 4; ++i) { const int dvr = 64 * dh + 16 * i + l15;
#pragma unroll
              for (int ks = 0; ks < 2; ++ks) bv[i][ks] = *(const LAS bf16x8*)(Vt + dvr * 72 + 32 * ks + 8 * quad);
#pragma unroll
              for (int ks = 0; ks < 4; ++ks) bs[i][ks] = *(const LAS bf16x8*)(Sb + dvr * 136 + 32 * ks + 8 * quad); }
#pragma unroll
          for (int i = 0; i < 4; ++i) o[i] = (f32x4){0.f, 0.f, 0.f, 0.f};
          __builtin_amdgcn_sched_barrier(0);
#pragma unroll
          for (int ks = 0; ks < 2; ++ks)
#pragma unroll
              for (int i = 0; i < 4; ++i) o[i] = MFMA16(ap[ks], bv[i][ks], o[i]);
#pragma unroll
          for (int ks = 0; ks < 4; ++ks)
#pragma unroll
              for (int i = 0; i < 4; ++i) o[i] = MFMA16(aq[ks], bs[i][ks], o[i]); }
        { f32x4 ss = o[0] * o[0] + o[1] * o[1] + o[2] * o[2] + o[3] * o[3];
#pragma unroll
          for (int j = 0; j < 4; ++j) { float v = ss[j]; v += __shfl_xor(v, 1); v += __shfl_xor(v, 2); v += __shfl_xor(v, 4); v += __shfl_xor(v, 8);
              if (l15 == 0) rss[(16 * tt + 4 * quad + j) * 2 + dh] = v; } }
        { bf16x8 ak[2];
#pragma unroll
          for (int ks = 0; ks < 2; ++ks) ak[ks] = *(const LAS bf16x8*)(KEt + (16 * w + l15) * 72 + 32 * ks + 8 * quad);
          f32x4 dec = *(const LAS f32x4*)(cend + 16 * w + 4 * quad);
#pragma unroll
          for (int j = 0; j < 4; ++j) dec[j] = __expf(dec[j]);
          bf16x8 ev[8][2];
#pragma unroll
          for (int dt = 0; dt < 8; ++dt)
#pragma unroll
              for (int ks = 0; ks < 2; ++ks) ev[dt][ks] = *(const LAS bf16x8*)(Vt + (16 * dt + l15) * 72 + 32 * ks + 8 * quad);
#pragma unroll
          for (int dt = 0; dt < 8; ++dt) S[dt] = S[dt] * dec;
          __builtin_amdgcn_sched_barrier(0);
#pragma unroll
          for (int ks = 0; ks < 2; ++ks)
#pragma unroll
              for (int dt = 0; dt < 8; ++dt) S[dt] = MFMA16(ak[ks], ev[dt][ks], S[dt]); }
        __syncthreads();
        float rsn[4];
#pragma unroll
        for (int j = 0; j < 4; ++j) { const f32x2 r2 = *(const LAS f32x2*)(rss + 2 * (16 * tt + 4 * quad + j)); rsn[j] = rsqrtf((r2.x + r2.y) * (1.f / 128.f) + EPS); }
#pragma unroll
        for (int i = 0; i < 4; ++i) { const float og = ogain[64 * dh + 16 * i + l15];
#pragma unroll
            for (int j = 0; j < 4; ++j) { const float val = o[i][j] * rsn[j] * og * bf1(gq[i][j]);
                MIX[(r0 + 16 * tt + 4 * quad + j) * 1024 + hc + 64 * dh + 16 * i + l15] = (bf16_t)(pk2(val, 0.f) & 0xffffu); } }
#pragma unroll
        for (int dt = 0; dt < 8; ++dt) { u32x2 sw; sw.x = pk2(S[dt][0], S[dt][1]); sw.y = pk2(S[dt][2], S[dt][3]);
            *(LAS u32x2*)(Sb + (16 * dt + l15) * 136 + 16 * w + 4 * quad) = sw; }
    }
#undef HG_LOAD
    __syncthreads();
}

DI void attn_item(const bf16_t* Qp, int ldq, const bf16_t* __restrict__ Kp, const bf16_t* __restrict__ Vp, int ldkv, int nkv, const float* __restrict__ bias, int q0, bool causal,
                  const bf16_t* Gp, bf16_t* Op, int ldo, bool gated, LAS unsigned char* lds) {
    int tid = threadIdx.x; asm volatile("" : "+v"(tid)); const int lane = tid & 63, w = __builtin_amdgcn_readfirstlane(tid >> 6), l15 = lane & 15, quad = lane >> 4;
    constexpr int ABUF = 64 * 72 * 2 * 2 + 256;
    bf16x8 bq[2][2];
#pragma unroll
    for (int qt = 0; qt < 2; ++qt)
#pragma unroll
        for (int ks = 0; ks < 2; ++ks) bq[qt][ks] = *(const bf16x8*)(Qp + (size_t)(32 * w + 16 * qt + l15) * ldq + 32 * ks + 8 * quad);
    const float dref = bias ? bias[q0] : 0.f;
    float mrun[2] = {-INFINITY, -INFINITY}, lsum[2] = {0.f, 0.f};
    f32x4 o[2][4];
#pragma unroll
    for (int qt = 0; qt < 2; ++qt)
#pragma unroll
        for (int dt = 0; dt < 4; ++dt) o[qt][dt] = (f32x4){0.f, 0.f, 0.f, 0.f};
    const int key_l = tid >> 3, ch = tid & 7, kp = tid >> 4, dvg = tid & 15;
    u32x4 kreg; u32x2 v0, v1; float breg = 0.f;
#define AT_LOAD(kt_) do { const size_t kr_ = (size_t)(kt_) * 64; kreg = *(const u32x4*)(Kp + (kr_ + key_l) * ldkv + 8 * ch); \
        v0 = *(const u32x2*)(Vp + (kr_ + 2 * kp) * ldkv + 4 * dvg); v1 = *(const u32x2*)(Vp + (kr_ + 2 * kp + 1) * ldkv + 4 * dvg); \
        if (tid < 64) breg = bias ? (dref - bias[kr_ + tid]) : 0.f; } while (0)
#define AT_STORE(buf_) do { LAS bf16_t* Ks_ = (LAS bf16_t*)(lds + (buf_) * ABUF); LAS bf16_t* Vt_ = Ks_ + 64 * 72; LAS float* bl_ = (LAS float*)(Vt_ + 64 * 72); \
        *(LAS u32x4*)(Ks_ + key_l * 72 + 8 * ch) = kreg; \
        _Pragma("unroll") for (int i = 0; i < 4; ++i) { const unsigned a = v0[i >> 1], c2 = v1[i >> 1]; \
            const unsigned lo = (i & 1) ? (a >> 16) : (a & 0xffffu), hi = (i & 1) ? (c2 >> 16) : (c2 & 0xffffu); \
            *(LAS unsigned*)(Vt_ + (4 * dvg + i) * 72 + 2 * kp) = lo | (hi << 16); } \
        if (tid < 64) bl_[tid] = breg; } while (0)
    AT_LOAD(0);
    const int qlo = q0 + 32 * w;
    AT_STORE(0);
    __syncthreads();
    for (int kt = 0; kt < nkv; ++kt) {
        if (kt) { AT_STORE(kt & 1); __syncthreads(); }
        if (kt + 1 < nkv) AT_LOAD(kt + 1);
        if (causal && 64 * kt > qlo + 31) continue;
        const LAS bf16_t* Ks = (const LAS bf16_t*)(lds + (kt & 1) * ABUF); const LAS bf16_t* Vt = Ks + 64 * 72; const LAS float* bl = (const LAS float*)(Vt + 64 * 72);
        f32x4 s[2][4];
        { bf16x8 ka[4][2]; f32x4 kb[4];
#pragma unroll
          for (int ky = 0; ky < 4; ++ky) { ka[ky][0] = *(const LAS bf16x8*)(Ks + (16 * ky + l15) * 72 + 8 * quad); ka[ky][1] = *(const LAS bf16x8*)(Ks + (16 * ky + l15) * 72 + 32 + 8 * quad);
              kb[ky] = *(const LAS f32x4*)(bl + 16 * ky + 4 * quad); }
          __builtin_amdgcn_sched_barrier(0);
#pragma unroll
          for (int ky = 0; ky < 4; ++ky)
#pragma unroll
              for (int qt = 0; qt < 2; ++qt) s[qt][ky] = MFMA16(ka[ky][0], bq[qt][0], kb[ky]);
#pragma unroll
          for (int ky = 0; ky < 4; ++ky)
#pragma unroll
              for (int qt = 0; qt < 2; ++qt) s[qt][ky] = MFMA16(ka[ky][1], bq[qt][1], s[qt][ky]); }
        if (causal && 64 * kt + 63 > qlo) {
#pragma unroll
            for (int qt = 0; qt < 2; ++qt)
#pragma unroll
                for (int ky = 0; ky < 4; ++ky)
#pragma unroll
                    for (int j = 0; j < 4; ++j) if (64 * kt + 16 * ky + 4 * quad + j > qlo + 16 * qt + l15) s[qt][ky][j] = -INFINITY;
        }
#pragma unroll
        for (int qt = 0; qt < 2; ++qt) {
            float tm = -INFINITY;
#pragma unroll
            for (int ky = 0; ky < 4; ++ky) tm = fmaxf(tm, fmaxf(fmaxf(s[qt][ky][0], s[qt][ky][1]), fmaxf(s[qt][ky][2], s[qt][ky][3])));
            tm = fmaxf(tm, __shfl_xor(tm, 16)); tm = fmaxf(tm, __shfl_xor(tm, 32));
            const float mn = fmaxf(mrun[qt], tm);
            const float alpha = __builtin_amdgcn_exp2f(mrun[qt] - mn);
            mrun[qt] = mn; float ps = 0.f;
#pragma unroll
            for (int ky = 0; ky < 4; ++ky)
#pragma unroll
                for (int j = 0; j < 4; ++j) { const float pv = __builtin_amdgcn_exp2f(s[qt][ky][j] - mn); s[qt][ky][j] = pv; ps += pv; }
            lsum[qt] = lsum[qt] * alpha + ps;
#pragma unroll
            for (int dt = 0; dt < 4; ++dt) o[qt][dt] *= alpha;
        }
#pragma unroll
        for (int ks2 = 0; ks2 < 2; ++ks2) {
            bf16x8 pb[2];
#pragma unroll
            for (int qt = 0; qt < 2; ++qt) { u32x4 pw; pw.x = pk2(s[qt][2 * ks2][0], s[qt][2 * ks2][1]); pw.y = pk2(s[qt][2 * ks2][2], s[qt][2 * ks2][3]);
                pw.z = pk2(s[qt][2 * ks2 + 1][0], s[qt][2 * ks2 + 1][1]); pw.w = pk2(s[qt][2 * ks2 + 1][2], s[qt][2 * ks2 + 1][3]); pb[qt] = __builtin_bit_cast(bf16x8, pw); }
            bf16x8 va[4];
#pragma unroll
            for (int dt = 0; dt < 4; ++dt) { const u32x2 lo = *(const LAS u32x2*)(Vt + (16 * dt + l15) * 72 + 32 * ks2 + 4 * quad), hi = *(const LAS u32x2*)(Vt + (16 * dt + l15) * 72 + 32 * ks2 + 16 + 4 * quad);
                u32x4 av; av.x = lo.x; av.y = lo.y; av.z = hi.x; av.w = hi.y; va[dt] = __builtin_bit_cast(bf16x8, av); }
            __builtin_amdgcn_sched_barrier(0);
#pragma unroll
            for (int dt = 0; dt < 4; ++dt)
#pragma unroll
                for (int qt = 0; qt < 2; ++qt) o[qt][dt] = MFMA16(va[dt], pb[qt], o[qt][dt]);
        }
    }
#undef AT_LOAD
#undef AT_STORE
#pragma unroll
    for (int qt = 0; qt < 2; ++qt) {
        float l = lsum[qt]; l += __shfl_xor(l, 16); l += __shfl_xor(l, 32);
        const float inv = 1.f / l;
        bf16_t* orow = Op + (size_t)(32 * w + 16 * qt + l15) * ldo + 4 * quad; const bf16_t* grow = Gp + (size_t)(32 * w + 16 * qt + l15) * ldo + 4 * quad;
#pragma unroll
        for (int dt = 0; dt < 4; ++dt) { f32x4 v = o[qt][dt] * inv;
            if (gated) { const u32x2 g = *(const u32x2*)(grow + 16 * dt); v[0] *= bflo(g.x); v[1] *= bfhi(g.x); v[2] *= bflo(g.y); v[3] *= bfhi(g.y); }
            u32x2 ow; ow.x = pk2(v[0], v[1]); ow.y = pk2(v[2], v[3]); *(u32x2*)(orow + 16 * dt) = ow; }
    }
    __syncthreads();
}
DI void fox_cumsum(const float* LFX, float* DL, int bh, int lane) {
    const float* src = LFX + (size_t)bh * 2048 + 32 * lane; float v[32]; float s = 0.f;
#pragma unroll
    for (int i = 0; i < 8; ++i) { const f32x4 t = *(const f32x4*)(src + 4 * i);
#pragma unroll
        for (int e = 0; e < 4; ++e) { s += t[e]; v[4 * i + e] = s; } }
    float incl = s;
#pragma unroll
    for (int off = 1; off < 64; off <<= 1) { const float t = __shfl_up(incl, off); if (lane >= off) incl += t; }
    const float excl = incl - s;
    float* dst = DL + (size_t)bh * 2048 + 32 * lane;
#pragma unroll
    for (int i = 0; i < 8; ++i) { f32x4 t;
#pragma unroll
        for (int e = 0; e < 4; ++e) t[e] = (v[4 * i + e] + excl) * LOG2E;
        *(f32x4*)(dst + 4 * i) = t; }
}
DI void mem_attn_item(int j, int l, bf16_t* MIX, const bf16_t* MK, const bf16_t* MV, LAS unsigned char* lds) {
    const int b = j >> 5, qb = (j >> 2) & 7, hd = j & 3;
    bf16_t* qo = MIX + ((size_t)b * SEQ + 256 * qb) * 1024 + 768 + 64 * hd;
    const size_t kvoff = ((size_t)l * MMEM + (size_t)b * NMEMT) * 256 + 64 * hd;
    attn_item(qo, 1024, MK + kvoff, MV + kvoff, 256, 4, nullptr, 0, false, qo, qo, 1024, false, lds);
}


typedef unsigned v4u __attribute__((ext_vector_type(4)));
#define XB_TMO      128
#define XB_XCNT(j)  (256  + 64 * (j))
#define XB_XSUB(j)  (1280 + 64 * (j))
#define XB_XGEN(j)  (2304 + 64 * (j))
#define XB_TOP      3328
#define XB_TOPGEN   3392
#define XCD_BAR_WORDS 3456
#define XB_SPIN_CAP (1u << 18)

__device__ __forceinline__ unsigned xb_ld(unsigned* p)              { return __hip_atomic_load(p, __ATOMIC_RELAXED, __HIP_MEMORY_SCOPE_AGENT); }
__device__ __forceinline__ unsigned xb_add(unsigned* p, unsigned v) { return __hip_atomic_fetch_add(p, v, __ATOMIC_RELAXED, __HIP_MEMORY_SCOPE_AGENT); }
__device__ __forceinline__ unsigned xb_xcc_id() { return (unsigned)__builtin_amdgcn_s_getreg((3 << 11) | 20) & 0xFu; }
#define XB_SPIN(cond, bar) do { unsigned _sp = 0; while (cond) { __builtin_amdgcn_s_sleep(1); \
    if ((++_sp & 255u) == 0u) { if (xb_ld(&(bar)[XB_TMO])) break; if (_sp > XB_SPIN_CAP) { atomicAdd(&(bar)[XB_TMO], 1u); break; } } } } while (0)

struct XcdBarrier {
    unsigned* bar; unsigned x;
    volatile LAS unsigned* st;
};

__device__ __forceinline__ XcdBarrier xcd_barrier_post(unsigned* bar, volatile LAS unsigned* st) {
    XcdBarrier b; b.bar = bar; b.x = xb_xcc_id(); b.st = st;
    if (threadIdx.x == 0) (void)xb_add(&bar[XB_XCNT(b.x)], 1u);
    return b;
}
__device__ __forceinline__ void xcd_barrier_complete(unsigned* bar, unsigned x, unsigned& nloc, unsigned& nx) {
    const unsigned G = gridDim.x * gridDim.y * gridDim.z;
    unsigned sum, cnt, mine, sp = 0u;
    for (;;) {
        sum = 0u; cnt = 0u; mine = 0u;
#pragma unroll
        for (unsigned j = 0; j < 16; ++j) { const unsigned c = xb_ld(&bar[XB_XCNT(j)]); sum += c; cnt += (c > 0u) ? 1u : 0u; mine = (j == x) ? c : mine; }
        if (sum == G) break;
        __builtin_amdgcn_s_sleep(1);
        if ((++sp & 255u) == 0u) { if (xb_ld(&bar[XB_TMO])) break; if (sp > XB_SPIN_CAP) { atomicAdd(&bar[XB_TMO], 1u); break; } }
    }
    nloc = mine > 0u ? mine : 1u; nx = cnt > 0u ? cnt : 1u;
}

__device__ __forceinline__ void xcd_barrier(const XcdBarrier& b) {
    asm volatile("s_waitcnt vmcnt(0)" ::: "memory");
    __syncthreads();
    if (threadIdx.x == 0) {
        unsigned* bar = b.bar;
        __builtin_amdgcn_s_waitcnt(0);
        unsigned nloc = b.st[0], nx = b.st[1];
        if (nloc == 0u) { xcd_barrier_complete(bar, b.x, nloc, nx); b.st[0] = nloc; b.st[1] = nx; }
        const unsigned old = xb_add(&bar[XB_XSUB(b.x)], 1u);
        const unsigned gen = old / nloc;
        if (old + 1u == (gen + 1u) * nloc) {
            __builtin_amdgcn_fence(__ATOMIC_RELEASE, "agent");
            asm volatile("s_waitcnt vmcnt(0)" ::: "memory");
            const unsigned og = xb_add(&bar[XB_TOP], 1u);
            const unsigned tg = og / nx;
            if (og + 1u == (tg + 1u) * nx) xb_add(&bar[XB_TOPGEN], 1u);
            else XB_SPIN(xb_ld(&bar[XB_TOPGEN]) == tg, bar);
            __builtin_amdgcn_fence(__ATOMIC_ACQUIRE, "agent");
            xb_add(&bar[XB_XGEN(b.x)], 1u);
            asm volatile("s_waitcnt vmcnt(0)" ::: "memory");
        } else {
            XB_SPIN(xb_ld(&bar[XB_XGEN(b.x)]) == gen, bar);
            __builtin_amdgcn_fence(__ATOMIC_ACQUIRE, "agent");
            asm volatile("s_waitcnt vmcnt(0)" ::: "memory");
        }
    }
    __syncthreads();
}

#define GRID_SYNC0() do { asm volatile("s_waitcnt vmcnt(0)" ::: "memory"); __syncthreads(); grid.sync(); __builtin_amdgcn_fence(__ATOMIC_ACQUIRE, "agent"); asm volatile("s_waitcnt vmcnt(0)" ::: "memory"); __syncthreads(); } while (0)
#define GRID_SYNC() do { XcdBarrier b_; b_.bar = (unsigned*)(wsp(p) + O_BAR); b_.x = xbar_x; asm volatile("" : "+s"(b_.x)); b_.st = (volatile LAS unsigned*)(lds + LDS_BARST); xcd_barrier(b_); } while (0)
DI unsigned char* wsp(const Params& p) { size_t z_ = 0; asm volatile("" : "+s"(z_)); return p.ws + z_; }
#define WSPTRS unsigned char* ws = wsp(p); int L_ = l, H_ = half; asm volatile("" : "+s"(L_), "+s"(H_)); (void)L_; (void)H_; bf16_t* XB = (bf16_t*)(ws + O_XB); bf16_t* ACT = (bf16_t*)(ws + O_ACT); bf16_t* QB = (bf16_t*)(ws + O_QB); bf16_t* LF = (bf16_t*)(ws + O_LF); \
    bf16_t* VB = (bf16_t*)(ws + O_VB); bf16_t* MIX = (bf16_t*)(ws + O_MIX); bf16_t* KSH = (bf16_t*)(ws + O_KSH); bf16_t* VSH = (bf16_t*)(ws + O_VSH); \
    float* LFX = (float*)(ws + O_LFX); float* DL = (float*)(ws + O_DL); bf16_t* MEMB = (bf16_t*)(ws + O_MEMB); bf16_t* MK = (bf16_t*)(ws + O_MK); bf16_t* MV = (bf16_t*)(ws + O_MV); \
    float* SSQ = (float*)(ws + O_SSQ); float* SSQM = (float*)(ws + O_SSQM); float* LBV = (float*)(ws + O_LBV); float* OUT = p.out; \
    (void)XB;(void)ACT;(void)QB;(void)LF;(void)VB;(void)MIX;(void)KSH;(void)VSH;(void)LFX;(void)DL;(void)MEMB;(void)MK;(void)MV;(void)SSQ;(void)SSQM;(void)LBV;(void)OUT;
__global__ void __launch_bounds__(NTHREADS) fwd_kernel(Params p) {
    extern __shared__ __attribute__((aligned(16))) unsigned char lds_raw[];
    LAS unsigned char* lds = (LAS unsigned char*)lds_raw;
    cg::grid_group grid = cg::this_grid();
    const int G = gridDim.x, blk = blockIdx.x, tid = threadIdx.x, lane = tid & 63, w = __builtin_amdgcn_readfirstlane(tid >> 6);

    if (tid < 16) ((LAS unsigned*)(lds + LDS_BARST))[tid] = 0u;
    __syncthreads();
    const unsigned xbar_x = xcd_barrier_post((unsigned*)(p.ws + O_BAR), (volatile LAS unsigned*)(lds + LDS_BARST)).x;
    {   const int l = 0, half = 0; WSPTRS
        LAS float* scr = (LAS float*)(lds + w * 16384);
        const int gw = blk * 8 + w, NGW = G * 8; int base = 0;
        conv_layer(p, ws, 0, base, gw, NGW, scr, lane);
        for (int l2 = 0; l2 < 4; ++l2) conv_job(MODE_MEMKV, p.in[8] + (size_t)l2 * DM * 512, nullptr, 512, DM, (bf16_t*)(ws + O_WMKV) + (size_t)l2 * 512 * DM, 16, p.in[7] + l2 * DM, base, gw, NGW, scr, lane);
        for (int m = gw; m < MTOK; m += NGW) row_to_bf16(p.in[0] + (size_t)m * DM, XB + (size_t)m * DM, SSQ + (size_t)m * 16, lane, true);
        for (int m = gw; m < MMEM; m += NGW) row_to_bf16(p.in[1] + (size_t)m * DM, MEMB + (size_t)m * DM, SSQM + m, lane, false);
        const int gt = blk * NTHREADS + tid;
        if (gt < 768) { LBV[gt] = 0.f; LBV[768 + gt] = 1.f / (1.f + __expf(p.in[12][gt] - p.in[12][768 + gt])); }
    }
    { int never_ = 0; asm volatile("" : "+s"(never_)); if (never_) GRID_SYNC0(); }
    GRID_SYNC();

    for (int l = 0; l < 4; ++l) {
        for (int half = 0; half < 2; ++half) {
            if (l == 2 && half == 0) { int t2 = threadIdx.x; asm volatile("" : "+v"(t2)); if ((t2 >> 6) == 0) { WSPTRS for (int bh = blk; bh < 96; bh += G) fox_cumsum(LFX, DL, bh, t2 & 63); } }
            {
                WSPTRS const bf16_t* Wgu = (const bf16_t*)(ws + (H_ ? O_WGU2 : O_WGU1) + L_ * SZ_WGU);
                pg8::Gemm g{XB, Wgu, MTOK, NGU, DM}; pg8::StaticOrder S; S.init(MTOK, NGU, G, blk);
                EpiGateUp E{ACT, SSQ};
                pg8::gemm_phase<EpiGateUp, pg8::StaticOrder, true, true>(lds, g, S, E);
            }
            if (l == 0 && half == 0) {
                WSPTRS const int nfull = ((MTOK / 256) * (NGU / 256)) % G;
                pg8::Gemm g{MEMB, (const bf16_t*)(ws + O_WMKV), MMEM, NMKV, DM}; pg8::StaticOrder S; S.init(MMEM, NMKV, G, (blk - nfull + G) % G);
                EpiMemKV E{SSQM, MK, MV, p.in[10]};
                pg8::gemm_phase<EpiMemKV, pg8::StaticOrder, true, true>(lds, g, S, E);
            }
            GRID_SYNC();
            {
                WSPTRS const bf16_t* Wd = (const bf16_t*)(ws + (H_ ? O_WD2 : O_WD1) + L_ * SZ_WD);
                pg8::Gemm g{ACT, Wd, MTOK, DM, DFF}; pg8::StaticOrder S; S.init(MTOK, DM, G, blk);
                EpiResid E{(L_ == 0 && H_ == 0) ? p.in[0] : nullptr, XB, (L_ == 3 && H_ == 1) ? OUT : nullptr, SSQ, 0.5f};
                pg8::gemm_phase<EpiResid, pg8::StaticOrder, true, true>(lds, g, S, E);
            }
            if (l == 3 && half == 1) break;
            GRID_SYNC();
            if (half == 0) {
                if (l < 2) {
                    {   WSPTRS pg8::Gemm g{XB, (const bf16_t*)(ws + O_WINA + L_ * SZ_WINA), MTOK, NINA - 256, DM}; pg8::StaticOrder S; S.init(MTOK, NINA - 256, G, blk);
                        EpiInA E{SSQ, QB, LF, VB, MIX, LBV + L_ * 768, p.in[9] + L_ * 64, 0, (L_ == 0) ? 1 : 0};
                        pg8::gemm_phase<EpiInA, pg8::StaticOrder, true, true>(lds, g, S, E); }
                    GRID_SYNC();
                    { WSPTRS
                    for (int c = blk; c < 48; c += G) hgrn_chain(QB, LF, VB, MIX, MIX, p.in[13] + L_ * 128, c / 6, c % 6, lds);
                    if (G > 48) { if (blk >= 48) {
                        for (int pm = blk - 48; pm < 64; pm += G - 48) {
                            pg8::Gemm g{XB, (const bf16_t*)(ws + O_WINA + L_ * SZ_WINA) + (size_t)(NINA - 256) * DM, MTOK, 256, DM}; OneUnit S1{pm};
                            EpiInA E{SSQ, QB, LF, VB, MIX, LBV + L_ * 768, p.in[9] + L_ * 64, 12};
                            pg8::gemm_phase<EpiInA, OneUnit, true, true>(lds, g, S1, E);
                            asm volatile("s_waitcnt vmcnt(0)" ::: "memory"); __syncthreads();
                            for (int hd = 0; hd < 4; ++hd) mem_attn_item(pm * 4 + hd, L_, MIX, MK, MV, lds);
                        }
                        int tq = threadIdx.x; asm volatile("" : "+v"(tq)); const int wq = __builtin_amdgcn_readfirstlane(tq >> 6);
                        LAS float* scr = (LAS float*)(lds + wq * 16384); const int gw = (blk - 48) * 8 + wq, NGW = (G - 48) * 8; int base = 0;
                        if (L_ == 0) { conv_layer(p, ws, 1, base, gw, NGW, scr, tq & 63); conv_layer(p, ws, 2, base, gw, NGW, scr, tq & 63); }
                        else { conv_layer(p, ws, 3, base, gw, NGW, scr, tq & 63); conv_job(MODE_KV, p.in[17], nullptr, KVSRC, DM, (bf16_t*)(ws + O_WKV), NKV / 32, p.in[16], base, gw, NGW, scr, tq & 63); }
                        __syncthreads(); } }
                    else { for (int pm = blk; pm < 64; pm += G) {
                            pg8::Gemm g{XB, (const bf16_t*)(ws + O_WINA + L_ * SZ_WINA) + (size_t)(NINA - 256) * DM, MTOK, 256, DM}; OneUnit S1{pm};
                            EpiInA E{SSQ, QB, LF, VB, MIX, LBV + L_ * 768, p.in[9] + L_ * 64, 12};
                            pg8::gemm_phase<EpiInA, OneUnit, true, true>(lds, g, S1, E);
                            asm volatile("s_waitcnt vmcnt(0)" ::: "memory"); __syncthreads();
                            for (int hd = 0; hd < 4; ++hd) mem_attn_item(pm * 4 + hd, L_, MIX, MK, MV, lds);
                        }
                        int tq = threadIdx.x; asm volatile("" : "+v"(tq)); const int wq = __builtin_amdgcn_readfirstlane(tq >> 6);
                        LAS float* scr = (LAS float*)(lds + wq * 16384); const int gw = blk * 8 + wq, NGW = G * 8; int base = 0;
                        if (L_ == 0) { conv_layer(p, ws, 1, base, gw, NGW, scr, tq & 63); conv_layer(p, ws, 2, base, gw, NGW, scr, tq & 63); }
                        else { conv_layer(p, ws, 3, base, gw, NGW, scr, tq & 63); conv_job(MODE_KV, p.in[17], nullptr, KVSRC, DM, (bf16_t*)(ws + O_WKV), NKV / 32, p.in[16], base, gw, NGW, scr, tq & 63); }
                        __syncthreads(); } }
                } else {
                    {   WSPTRS pg8::Gemm g{XB, (const bf16_t*)(ws + O_WINB + (L_ - 2) * SZ_WINB), MTOK, NINB, DM}; pg8::StaticOrder S; S.init(MTOK, NINB, G, blk);
                        EpiInB E{SSQ, QB, MIX, p.in[15] + (L_ - 2) * 64, p.in[9] + L_ * 64};
                        pg8::gemm_phase<EpiInB, pg8::StaticOrder, true, true>(lds, g, S, E); }
                    GRID_SYNC();
                    { WSPTRS
                    for (int r = 0;; ++r) {
                        const int idx = r * G + ((r & 1) ? (G - 1 - blk) : blk);
                        if (r * G >= 1024) break;
                        if (idx >= 1024) continue;
                        if (idx < 768) { const int qb = 7 - idx / 96, bh = idx % 96, b = bh / 12, h = bh % 12;
                            bf16_t* op = MIX + ((size_t)b * SEQ + 256 * qb) * 1024 + 64 * h;
                            attn_item(QB + ((size_t)b * SEQ + 256 * qb) * 768 + 64 * h, 768, KSH + (size_t)b * SEQ * 768 + 64 * h, VSH + (size_t)b * SEQ * 768 + 64 * h, 768, 4 * (qb + 1),
                                      DL + (size_t)bh * 2048, 256 * qb, true, op, op, 1024, true, lds);
                        } else mem_attn_item(idx - 768, L_, MIX, MK, MV, lds);
                    } }
                }
                GRID_SYNC();
                {
                    WSPTRS pg8::Gemm g{MIX, (const bf16_t*)(ws + O_WOUT + L_ * SZ_WOUT), MTOK, DM, DM}; pg8::StaticOrder S; S.init(MTOK, DM, G, blk);
                    EpiResid E{nullptr, XB, nullptr, SSQ, 1.0f};
                    pg8::gemm_phase<EpiResid, pg8::StaticOrder, true, true>(lds, g, S, E);
                }
                GRID_SYNC();
            }
        }
        if (l == 1) {
            const int half = 0; WSPTRS pg8::Gemm g{XB, (const bf16_t*)(ws + O_WKV), MTOK, NKV, DM}; pg8::StaticOrder S; S.init(MTOK, NKV, G, blk);
            EpiKV E{SSQ, KSH, VSH, LFX, p.in[19], p.in[18]};
            pg8::gemm_phase<EpiKV, pg8::StaticOrder, true, true>(lds, g, S, E);
            GRID_SYNC();
        }
    }
}

extern "C" void kernel_launch(void* const* d_in, const int* in_sizes, int n_in, void* d_out, int out_size, void* d_ws, size_t ws_size, hipStream_t stream) {
    static int grid = 0;
    if (grid == 0) {
        if (n_in != 25 || out_size != MTOK * DM || ws_size < WS_END) { fprintf(stderr, "kernel_launch: unexpected problem (n_in %d, out %d, ws %zu, need %zu)\n", n_in, out_size, ws_size, (size_t)WS_END); grid = -1; return; }
        int dev = 0, cus = 0, per_cu = 0;
        (void)hipGetDevice(&dev); (void)hipDeviceGetAttribute(&cus, hipDeviceAttributeMultiprocessorCount, dev);
        (void)hipFuncSetAttribute((const void*)fwd_kernel, hipFuncAttributeMaxDynamicSharedMemorySize, LDS_BYTES);
        if (hipOccupancyMaxActiveBlocksPerMultiprocessor(&per_cu, (const void*)fwd_kernel, NTHREADS, LDS_BYTES) != hipSuccess || per_cu < 1) per_cu = 1;
        (void)hipGetLastError();
        grid = cus * per_cu; if (grid < 1) grid = 256;
    }
    if (grid < 0) return;
    Params p{};
    for (int i = 0; i < 25; ++i) p.in[i] = (const float*)d_in[i];
    p.out = (float*)d_out; p.ws = (unsigned char*)d_ws;
    if (hipMemsetAsync((unsigned char*)d_ws + O_BAR, 0, XCD_BAR_WORDS_C * 4, stream) != hipSuccess) { fprintf(stderr, "kernel_launch: memset of the barrier words failed\n"); return; }
    void* args[] = {&p};
    hipError_t e = hipLaunchCooperativeKernel((const void*)fwd_kernel, dim3(grid), dim3(NTHREADS), args, LDS_BYTES, stream);
    if (e != hipSuccess) fprintf(stderr, "cooperative launch failed: %s (grid %d)\n", hipGetErrorString(e), grid);
}
```

```cpp
#include <hip/hip_runtime.h>
#include <hip/hip_cooperative_groups.h>
#include <cstdio>
#include <cstdint>
namespace cg = cooperative_groups;
namespace pg8 {
#define PG8_LAS __attribute__((address_space(3)))
typedef unsigned short bf16_t;
typedef short bf16x8 __attribute__((ext_vector_type(8)));
typedef float f32x4 __attribute__((ext_vector_type(4)));
typedef unsigned u32x4 __attribute__((ext_vector_type(4)));
constexpr int BM = 256, BK = 64, HALF = 128, HTB = HALF * BK * 2  , STAGE_BYTES = 8 * HTB, NXCD = 8, WGM = 4;

__host__ __device__ __forceinline__ int lds_byte(int r, int c) { const int st = (r >> 4) * 2 + (c >> 5), rr = r & 15, cc = c & 31, ob = rr * 64 + cc * 2; return st * 1024 + (ob ^ (((ob >> 9) & 1) << 5)); }
__host__ __device__ __forceinline__ void stage_rc(int b, int& R, int& C) { const int st = b / 1024, sb = b % 1024, swz = sb ^ (((sb >> 9) & 1) << 5); R = (st >> 1) * 16 + swz / 64; C = (st & 1) * 32 + (swz % 64) / 2; }
__host__ __device__ __forceinline__ int perm32(int rho) { const int n = rho >> 4, i = rho & 15; return 8 * (i >> 2) + 4 * n + (i & 3); }

struct Unit { int pm, pn; };
struct Gemm { const bf16_t* A; const bf16_t* Bt; int M, N, K; };

struct StaticOrder {
    int nM, nN, nwg, G, c;
    __host__ __device__ void init(int M, int N, int G_, int c_) { nM = M / BM; nN = N / BM; nwg = nM * nN; G = G_; c = c_; }
    __host__ __device__ bool next(int i, Unit& u) const {
        const long L = (long)i * G + c; if (L >= nwg) return false;
        int wgid = (int)L; { const int q = nwg / NXCD, r = nwg % NXCD, xcd = wgid % NXCD, off = wgid / NXCD; wgid = (xcd < r ? xcd * (q + 1) : r * (q + 1) + (xcd - r) * q) + off; }
        const int nig = WGM * nN, gid = wgid / nig, fm = gid * WGM, gsz = (nM - fm) < WGM ? (nM - fm) : WGM;
        u.pm = fm + ((wgid % nig) % gsz); u.pn = (wgid % nig) / gsz; return true;
    }
    __device__ __forceinline__ void a_ready(const Unit&) const {}
    __device__ __forceinline__ void done(const Unit&) const {}
};

template <class Epi, class Sched, bool ALIGN_EPI = false, bool SP2 = false>
__device__ __forceinline__ void gemm_phase(PG8_LAS unsigned char* lds, const Gemm g, const Sched& S, const Epi& E) {
    int tid = threadIdx.x; asm volatile("" : "+v"(tid)); const int wid = __builtin_amdgcn_readfirstlane(tid >> 6), lane = tid & 63, wr = wid >> 2, wc = wid & 3, fr = lane & 15, fq = lane >> 4;
    const int K = g.K, nt = K / BK;
    unsigned voffA[2], voffB[2];
#pragma unroll
    for (int i = 0; i < 2; ++i) { int R, C; stage_rc(tid * 16 + i * 8192, R, C); const int Rb = Epi::PERM ? ((R & ~31) + perm32(R & 31)) : R;
        voffA[i] = (unsigned)(R * K + C) * 2u; voffB[i] = (unsigned)(Rb * K + C) * 2u; }
    const size_t kstep = (size_t)(BK * 2);
    const size_t hstep = (size_t)HALF * K * 2;
    const size_t tstep = 2 * hstep;
    const unsigned ldsw = (unsigned)wid * 1024u;
    const int aoff = lds_byte(wr * 64 + fr, fq * 8), boff = lds_byte(wc * 32 + fr, fq * 8);
#define PG8_SA(b, h) (((b) * 2 + (h)) * HTB)
#define PG8_SB(b, h) ((4 + (b) * 2 + (h)) * HTB)
#define PG8_STAGE(bufoff, gbase, voff) do { _Pragma("unroll") for (int _i = 0; _i < 2; ++_i) \
        __builtin_amdgcn_global_load_lds((const unsigned*)((const char*)(gbase) + (voff)[_i]), (PG8_LAS unsigned*)(lds + (bufoff) + ldsw + _i * 8192), 16, 0, 0); } while (0)
#define PG8_LDA(dst, b, h) do { _Pragma("unroll") for (int m = 0; m < 4; ++m) _Pragma("unroll") for (int k = 0; k < 2; ++k) dst[m][k] = *(const PG8_LAS bf16x8*)(lds + PG8_SA(b, h) + aoff + m * 2048 + k * 1024); } while (0)
#define PG8_LDB(dst, b, h) do { _Pragma("unroll") for (int n = 0; n < 2; ++n) _Pragma("unroll") for (int k = 0; k < 2; ++k) dst[n][k] = *(const PG8_LAS bf16x8*)(lds + PG8_SB(b, h) + boff + n * 2048 + k * 1024); } while (0)
#define PG8_MMA(ai, bj, At, Bt) do { __builtin_amdgcn_s_setprio(1); _Pragma("unroll") for (int m = 0; m < 4; ++m) _Pragma("unroll") for (int n = 0; n < 2; ++n) _Pragma("unroll") for (int k = 0; k < 2; ++k) \
        acc[ai][bj][m][n] = __builtin_amdgcn_mfma_f32_16x16x32_bf16(Bt[n][k], At[m][k], acc[ai][bj][m][n], 0, 0, 0); __builtin_amdgcn_s_setprio(0); } while (0)
#define PG8_WAIT_V(n) asm volatile("s_waitcnt vmcnt(" #n ")" ::: "memory")
#define PG8_WAIT_L(n) asm volatile("s_waitcnt lgkmcnt(" #n ")" ::: "memory")
#define PG8_BAR __builtin_amdgcn_s_barrier()
#define PG8_SCHED __builtin_amdgcn_sched_barrier(0)
    Unit cur, nxt; int ui = 0;
    if (!S.next(0, cur)) return;
    f32x4 acc[2][2][4][2];
#pragma unroll
    for (int a = 0; a < 2; ++a)
#pragma unroll
        for (int b = 0; b < 2; ++b)
#pragma unroll
            for (int m = 0; m < 4; ++m)
#pragma unroll
                for (int n = 0; n < 2; ++n) acc[a][b][m][n] = (f32x4){0.f, 0.f, 0.f, 0.f};
    bf16x8 At[4][2], B0[2][2], B1[2][2];
    const char* cA = (const char*)g.A + (size_t)cur.pm * tstep; const char* cB = (const char*)g.Bt + (size_t)cur.pn * tstep;
    S.a_ready(cur);
    if constexpr (SP2) {
        PG8_STAGE(PG8_SB(0, 0), cB, voffB); PG8_STAGE(PG8_SB(0, 1), cB + hstep, voffB); PG8_STAGE(PG8_SA(0, 0), cA, voffA); PG8_STAGE(PG8_SA(0, 1), cA + hstep, voffA);
        if (wr == 1) PG8_BAR;
        PG8_WAIT_V(2); PG8_BAR;
        PG8_STAGE(PG8_SB(1, 0), cB + kstep, voffB); PG8_STAGE(PG8_SA(1, 0), cA + kstep, voffA); PG8_STAGE(PG8_SB(1, 1), cB + hstep + kstep, voffB);
        PG8_WAIT_V(6); PG8_BAR;
    } else {
        PG8_STAGE(PG8_SB(0, 0), cB, voffB); PG8_STAGE(PG8_SA(0, 0), cA, voffA); PG8_STAGE(PG8_SB(0, 1), cB + hstep, voffB); PG8_STAGE(PG8_SA(0, 1), cA + hstep, voffA);
        if (wr == 1) PG8_BAR;
        PG8_WAIT_V(4); PG8_BAR;
        PG8_STAGE(PG8_SB(1, 0), cB + kstep, voffB); PG8_STAGE(PG8_SA(1, 0), cA + kstep, voffA); PG8_STAGE(PG8_SB(1, 1), cB + hstep + kstep, voffB);
        PG8_WAIT_V(6); PG8_BAR;
    }
    for (;;) {
        const bool has_next = S.next(ui + 1, nxt);
        const char* nA = has_next ? (const char*)g.A + (size_t)nxt.pm * tstep : cA; const char* nB = has_next ? (const char*)g.Bt + (size_t)nxt.pn * tstep : cB;
        for (int t = 0; t < nt; t += 2) {
            const bool last = (t == nt - 2);
            const char* a1 = cA + (size_t)(t + 1) * kstep;
            const char* a2 = last ? nA : cA + (size_t)(t + 2) * kstep; const char* b2 = last ? nB : cB + (size_t)(t + 2) * kstep;
            const char* a3 = a2 + kstep; const char* b3 = b2 + kstep;
            if (last && has_next) S.a_ready(nxt);
            if constexpr (SP2) {
            PG8_LDB(B0, 0, 0); PG8_LDB(B1, 0, 1); PG8_SCHED; PG8_LDA(At, 0, 0); PG8_STAGE(PG8_SA(1, 1), a1 + hstep, voffA);
            PG8_WAIT_V(8); PG8_WAIT_L(0); PG8_BAR; PG8_MMA(0, 0, At, B0); PG8_MMA(0, 1, At, B1); PG8_BAR; PG8_SCHED;
            PG8_LDA(At, 0, 1); PG8_STAGE(PG8_SB(0, 0), b2, voffB); PG8_STAGE(PG8_SB(0, 1), b2 + hstep, voffB); PG8_STAGE(PG8_SA(0, 0), a2, voffA);
            PG8_WAIT_V(8); PG8_WAIT_L(0); PG8_BAR; PG8_MMA(1, 0, At, B0); PG8_MMA(1, 1, At, B1); PG8_BAR; PG8_SCHED;
            PG8_LDB(B0, 1, 0); PG8_LDB(B1, 1, 1); PG8_SCHED; PG8_LDA(At, 1, 0); PG8_STAGE(PG8_SA(0, 1), a2 + hstep, voffA);
            PG8_WAIT_V(8); PG8_WAIT_L(0); PG8_BAR; PG8_MMA(0, 0, At, B0); PG8_MMA(0, 1, At, B1); PG8_BAR; PG8_SCHED;
            PG8_LDA(At, 1, 1); PG8_STAGE(PG8_SB(1, 0), b3, voffB); PG8_STAGE(PG8_SB(1, 1), b3 + hstep, voffB); PG8_STAGE(PG8_SA(1, 0), a3, voffA);
            PG8_WAIT_V(8); PG8_WAIT_L(0); PG8_BAR; PG8_MMA(1, 0, At, B0); PG8_MMA(1, 1, At, B1); PG8_BAR; PG8_SCHED;
            } else {
            PG8_LDB(B0, 0, 0); PG8_SCHED; PG8_LDA(At, 0, 0); PG8_STAGE(PG8_SA(1, 1), a1 + hstep, voffA);
            PG8_WAIT_L(8); PG8_BAR; PG8_WAIT_L(0); PG8_MMA(0, 0, At, B0); PG8_BAR; PG8_SCHED;
            PG8_LDB(B1, 0, 1); PG8_STAGE(PG8_SB(0, 0), b2, voffB);
            PG8_BAR; PG8_WAIT_L(0); PG8_MMA(0, 1, At, B1); PG8_BAR;
            PG8_LDA(At, 0, 1); PG8_STAGE(PG8_SA(0, 0), a2, voffA);
            PG8_BAR; PG8_WAIT_L(0); PG8_MMA(1, 0, At, B0); PG8_BAR; PG8_SCHED;
            PG8_STAGE(PG8_SB(0, 1), b2 + hstep, voffB);
            PG8_WAIT_V(6); PG8_BAR; PG8_MMA(1, 1, At, B1); PG8_BAR;
            PG8_LDB(B0, 1, 0); PG8_SCHED; PG8_LDA(At, 1, 0); PG8_STAGE(PG8_SA(0, 1), a2 + hstep, voffA);
            PG8_WAIT_L(8); PG8_BAR; PG8_WAIT_L(0); PG8_MMA(0, 0, At, B0); PG8_BAR; PG8_SCHED;
            PG8_LDB(B1, 1, 1); PG8_STAGE(PG8_SB(1, 0), b3, voffB);
            PG8_BAR; PG8_WAIT_L(0); PG8_MMA(0, 1, At, B1); PG8_BAR;
            PG8_LDA(At, 1, 1); PG8_STAGE(PG8_SA(1, 0), a3, voffA);
            PG8_BAR; PG8_WAIT_L(0); PG8_MMA(1, 0, At, B0); PG8_BAR; PG8_SCHED;
            PG8_STAGE(PG8_SB(1, 1), b3 + hstep, voffB);
            PG8_WAIT_V(6); PG8_BAR; PG8_MMA(1, 1, At, B1); PG8_BAR;
            }
        }
        if constexpr (ALIGN_EPI) { if (wr == 0) PG8_BAR; }
        if constexpr (!Epi::AFTER_DRAIN) { E(acc, cur, wr, wc, fr, fq); S.done(cur); }
        if (!has_next) break;
#pragma unroll
        for (int a = 0; a < 2; ++a)
#pragma unroll
            for (int b = 0; b < 2; ++b)
#pragma unroll
                for (int m = 0; m < 4; ++m)
#pragma unroll
                    for (int n = 0; n < 2; ++n) acc[a][b][m][n] = (f32x4){0.f, 0.f, 0.f, 0.f};
        cur = nxt; cA = nA; cB = nB; ++ui;
        if constexpr (ALIGN_EPI) { if (wr == 1) PG8_BAR; }
    }
    PG8_WAIT_V(0);
    if constexpr (!ALIGN_EPI) { if (wr == 0) PG8_BAR; }
    PG8_BAR;
    if constexpr (Epi::AFTER_DRAIN) { E.fused(acc, cur, wr, wc, fr, fq, lds, wid, lane); S.done(cur); }
#undef PG8_SA
#undef PG8_SB
#undef PG8_STAGE
#undef PG8_LDA
#undef PG8_LDB
#undef PG8_MMA
#undef PG8_WAIT_V
#undef PG8_WAIT_L
#undef PG8_BAR
#undef PG8_SCHED
}
}

#define DI __device__ __forceinline__
#define LAS __attribute__((address_space(3)))
using pg8::bf16_t; using pg8::bf16x8; using pg8::f32x4; using pg8::u32x4; using pg8::Unit;
typedef unsigned u32x2 __attribute__((ext_vector_type(2)));
typedef float f32x2 __attribute__((ext_vector_type(2)));
typedef __bf16 bf16x2_t __attribute__((ext_vector_type(2)));

constexpr int DM = 1024, BATCH = 8, SEQ = 2048, MTOK = BATCH * SEQ, NMEMT = 256, MMEM = BATCH * NMEMT;
constexpr int DFF = 2816, NGU = 2 * DFF, NINA = 3328, NINB = 1792, NKV = 1792, KVSRC = 1548, NMKV = 2048;
constexpr float EPS = 1e-6f, LOG2E = 1.4426950408889634f, QSCALE = 0.125f * 1.4426950408889634f;
constexpr int NTHREADS = 512, LDS_BYTES = 147456, XCD_BAR_WORDS_C = 3456, LDS_BARST = LDS_BYTES - 64;

constexpr size_t SZ_WGU = (size_t)NGU * DM * 2, SZ_WD = (size_t)DM * DFF * 2, SZ_WINA = (size_t)NINA * DM * 2, SZ_WINB = (size_t)NINB * DM * 2,
                 SZ_WKV = (size_t)NKV * DM * 2, SZ_WOUT = (size_t)DM * DM * 2, SZ_WMKV = (size_t)NMKV * DM * 2;
constexpr size_t O_WGU1 = 0, O_WD1 = O_WGU1 + 4 * SZ_WGU, O_WGU2 = O_WD1 + 4 * SZ_WD, O_WD2 = O_WGU2 + 4 * SZ_WGU, O_WINA = O_WD2 + 4 * SZ_WD,
                 O_WINB = O_WINA + 2 * SZ_WINA, O_WKV = O_WINB + 2 * SZ_WINB, O_WOUT = O_WKV + SZ_WKV, O_WMKV = O_WOUT + 4 * SZ_WOUT,
                 O_XB = O_WMKV + SZ_WMKV, O_U = O_XB + (size_t)MTOK * DM * 2;
constexpr size_t O_ACT = O_U, O_QB = O_U, O_LF = O_QB + (size_t)MTOK * 768 * 2, O_VB = O_LF + (size_t)MTOK * 768 * 4, O_MIX = O_VB + (size_t)MTOK * 768 * 2;
constexpr size_t SZ_U = (size_t)MTOK * 768 * 8 + (size_t)MTOK * 1024 * 2;
static_assert(SZ_U >= (size_t)MTOK * DFF * 2, "U region holds ACT");
constexpr size_t O_KSH = O_U + SZ_U, O_VSH = O_KSH + (size_t)MTOK * 768 * 2, O_LFX = O_VSH + (size_t)MTOK * 768 * 2, O_DL = O_LFX + 96 * 2048 * 4,
                 O_MEMB = O_DL + 96 * 2048 * 4, O_MK = O_MEMB + (size_t)MMEM * DM * 2, O_MV = O_MK + 4 * (size_t)MMEM * 256 * 2,
                 O_SSQ = O_MV + 4 * (size_t)MMEM * 256 * 2, O_SSQM = O_SSQ + 16 * (size_t)MTOK * 4, O_LBV = O_SSQM + (size_t)MMEM * 4, O_BAR = O_LBV + 2 * 768 * 4, WS_END = O_BAR + XCD_BAR_WORDS_C * 4;

struct Params { const float* in[25]; float* out; unsigned char* ws; };

DI unsigned pk2(float lo, float hi) { f32x2 v = {lo, hi}; bf16x2_t b = __builtin_convertvector(v, bf16x2_t); return __builtin_bit_cast(unsigned, b); }
typedef _Float16 half2_t __attribute__((ext_vector_type(2)));
DI unsigned pkh(float lo, float hi) { f32x2 v = {lo, hi}; half2_t h = __builtin_convertvector(v, half2_t); return __builtin_bit_cast(unsigned, h); }
DI float hlo(unsigned u) { const half2_t h = __builtin_bit_cast(half2_t, u); return (float)h[0]; }
DI float hhi(unsigned u) { const half2_t h = __builtin_bit_cast(half2_t, u); return (float)h[1]; }
DI u32x4 pack8h(f32x4 a, f32x4 b) { u32x4 w; w.x = pkh(a[0], a[1]); w.y = pkh(a[2], a[3]); w.z = pkh(b[0], b[1]); w.w = pkh(b[2], b[3]); return w; }
DI float bflo(unsigned u) { return __uint_as_float(u << 16); }
DI float bfhi(unsigned u) { return __uint_as_float(u & 0xffff0000u); }
DI float bf1(bf16_t h) { return __uint_as_float((unsigned)h << 16); }
DI u32x4 pack8(f32x4 a, f32x4 b) { u32x4 w; w.x = pk2(a[0], a[1]); w.y = pk2(a[2], a[3]); w.z = pk2(b[0], b[1]); w.w = pk2(b[2], b[3]); return w; }
DI float silu_f(float x) { return x * __builtin_amdgcn_rcpf(1.f + __expf(-x)); }
DI float sigm_f(float x) { return __builtin_amdgcn_rcpf(1.f + __expf(-x)); }
DI float logsig_f(float z) { return fminf(z, 0.f) - __logf(1.f + __expf(-fabsf(z))); }
DI float wave_sum(float v) {
#pragma unroll
    for (int o = 1; o < 64; o <<= 1) v += __shfl_xor(v, o);
    return v;
}
DI float row_rstd(const float* ssq, int row, int fq) {
    const f32x4 a = *(const f32x4*)(ssq + (size_t)row * 16 + 4 * fq); float t = (a[0] + a[1]) + (a[2] + a[3]);
    t += __shfl_xor(t, 16); t += __shfl_xor(t, 32); return rsqrtf(t * (1.f / DM) + EPS); }
#define MFMA16(a, b, c) __builtin_amdgcn_mfma_f32_16x16x32_bf16((a), (b), (c), 0, 0, 0)

#define EPI_ROW_RSTD(ssq_) float rs[2][4]; \
    _Pragma("unroll") for (int ai = 0; ai < 2; ++ai) _Pragma("unroll") for (int m = 0; m < 4; ++m) rs[ai][m] = row_rstd(ssq_, row0 + ai * 128 + m * 16, fq);
struct EpiGateUp {
    static constexpr bool PERM = true, AFTER_DRAIN = false;
    bf16_t* O; const float* ssq;
    DI void operator()(f32x4 (&acc)[2][2][4][2], const Unit& u, int wr, int wc, int fr, int fq) const {
        const int row0 = u.pm * 256 + wr * 64 + fr, col0 = u.pn * 128 + wc * 32 + 8 * fq;
        EPI_ROW_RSTD(ssq)
#pragma unroll
        for (int ai = 0; ai < 2; ++ai)
#pragma unroll
            for (int m = 0; m < 4; ++m) {
                const int row = row0 + ai * 128 + m * 16; const float r1 = rs[ai][m];
                f32x4 o[2];
#pragma unroll
                for (int n = 0; n < 2; ++n) {
                    const f32x4 g = acc[ai][0][m][n] * r1, v = acc[ai][1][m][n] * r1;
#pragma unroll
                    for (int e = 0; e < 4; ++e) o[n][e] = silu_f(g[e]) * v[e];
                }
                *(u32x4*)(O + (size_t)row * DFF + col0) = pack8(o[0], o[1]);
            }
    }
};
struct EpiResid {
    static constexpr bool PERM = true, AFTER_DRAIN = false;
    const float* xin32; bf16_t* xb; float* xout32; float* ssq_out; float scale;
    DI void operator()(f32x4 (&acc)[2][2][4][2], const Unit& u, int wr, int wc, int fr, int fq) const {
        const int row0 = u.pm * 256 + wr * 64 + fr, col0 = u.pn * 256 + wc * 32 + 8 * fq;
        u32x4 cur[2], nxt[2];
        if (!xin32) {
#pragma unroll
            for (int bj = 0; bj < 2; ++bj) cur[bj] = *(const u32x4*)(xb + (size_t)row0 * DM + col0 + bj * 128);
        }
#pragma unroll
        for (int r = 0; r < 8; ++r) {
            const int ai = r >> 2, m = r & 3; const int row = row0 + ai * 128 + m * 16;
            f32x4 xo[2][2];
            if (xin32) {
#pragma unroll
                for (int bj = 0; bj < 2; ++bj) { const size_t off = (size_t)row * DM + col0 + bj * 128; xo[bj][0] = *(const f32x4*)(xin32 + off); xo[bj][1] = *(const f32x4*)(xin32 + off + 4); }
            } else {
                if (r < 7) { const int rown = row0 + ((r + 1) >> 2) * 128 + ((r + 1) & 3) * 16;
#pragma unroll
                    for (int bj = 0; bj < 2; ++bj) nxt[bj] = *(const u32x4*)(xb + (size_t)rown * DM + col0 + bj * 128); }
#pragma unroll
                for (int bj = 0; bj < 2; ++bj) { const u32x4 c = cur[bj];
                    xo[bj][0] = (f32x4){bflo(c.x), bfhi(c.x), bflo(c.y), bfhi(c.y)}; xo[bj][1] = (f32x4){bflo(c.z), bfhi(c.z), bflo(c.w), bfhi(c.w)}; }
            }
            float ss = 0.f;
#pragma unroll
            for (int bj = 0; bj < 2; ++bj) {
                const size_t off = (size_t)row * DM + col0 + bj * 128;
                const f32x4 a = xo[bj][0] + acc[ai][bj][m][0] * scale, b = xo[bj][1] + acc[ai][bj][m][1] * scale;
                *(u32x4*)(xb + off) = pack8(a, b);
                if (xout32) { *(f32x4*)(xout32 + off) = a; *(f32x4*)(xout32 + off + 4) = b; }
                ss += (a[0] * a[0] + a[1] * a[1]) + (a[2] * a[2] + a[3] * a[3]) + (b[0] * b[0] + b[1] * b[1]) + (b[2] * b[2] + b[3] * b[3]);
            }
            ss += __shfl_xor(ss, 16); ss += __shfl_xor(ss, 32);
            if (fq == 0) ssq_out[(size_t)row * 16 + u.pn * 4 + wc] = ss;
            if (!xin32 && r < 7) { cur[0] = nxt[0]; cur[1] = nxt[1]; }
        }
    }
};
DI void headnorm_store(const f32x4 (&z)[2][2], const f32x4 (&g)[2][2], float post, bf16_t* dst, int fq) {
    float ss = 0.f;
#pragma unroll
    for (int bj = 0; bj < 2; ++bj)
#pragma unroll
        for (int n = 0; n < 2; ++n) { const f32x4 t = z[bj][n]; ss += (t[0] * t[0] + t[1] * t[1]) + (t[2] * t[2] + t[3] * t[3]); }
    ss += __shfl_xor(ss, 16); ss += __shfl_xor(ss, 32);
    const float rn = rsqrtf(ss * (1.f / 64.f) + EPS) * post;
#pragma unroll
    for (int bj = 0; bj < 2; ++bj) *(u32x4*)(dst + 32 * bj + 8 * fq) = pack8(z[bj][0] * rn * g[bj][0], z[bj][1] * rn * g[bj][1]);
}
#define EPI_LOAD_GAIN(gv_, gain_) f32x4 gv_[2][2]; \
    _Pragma("unroll") for (int bj = 0; bj < 2; ++bj) { gv_[bj][0] = *(const f32x4*)((gain_) + 32 * bj + 8 * fq); gv_[bj][1] = *(const f32x4*)((gain_) + 32 * bj + 8 * fq + 4); }
#define EPI_Z() asm volatile("" ::: "memory"); f32x4 z[2][2]; \
    _Pragma("unroll") for (int bj = 0; bj < 2; ++bj) _Pragma("unroll") for (int n = 0; n < 2; ++n) z[bj][n] = acc[ai][bj][m][n] * rs[ai][m];
struct EpiInA {
    static constexpr bool PERM = true, AFTER_DRAIN = false;
    const float* ssq; bf16_t* QB; bf16_t* LF  ; bf16_t* VB; bf16_t* MIX; const float* lb; const float* mqgain; int pn_off; int lbzero = 0;
    DI void operator()(f32x4 (&acc)[2][2][4][2], const Unit& u, int wr, int wc, int fr, int fq) const {
        const int t = u.pn + pn_off, row0 = u.pm * 256 + wr * 64 + fr, c8 = wc * 32 + 8 * fq;
        EPI_ROW_RSTD(ssq)
        EPI_LOAD_GAIN(gv, mqgain)
#pragma unroll
        for (int ai = 0; ai < 2; ++ai)
#pragma unroll
            for (int m = 0; m < 4; ++m) {
                const int row = row0 + ai * 128 + m * 16; EPI_Z()
                if (t < 3) {
#pragma unroll
                    for (int bj = 0; bj < 2; ++bj) { f32x4 a = z[bj][0], b = z[bj][1];
#pragma unroll
                        for (int e = 0; e < 4; ++e) { a[e] = silu_f(a[e]); b[e] = silu_f(b[e]); }
                        *(u32x4*)(QB + (size_t)row * 768 + t * 256 + bj * 128 + c8) = pack8(a, b); }
                } else if (t < 6) {
#pragma unroll
                    for (int bj = 0; bj < 2; ++bj) { const int col = (t - 3) * 256 + bj * 128 + c8;
                        const f32x4 l0 = *(const f32x4*)(lb + col), l1 = *(const f32x4*)(lb + col + 4); f32x4 a, b;
#pragma unroll
                        for (int e = 0; e < 4; ++e) {
                            const float la = logsig_f(z[bj][0][e]), lc = logsig_f(z[bj][1][e]);
                            if (lbzero) { a[e] = la; b[e] = lc; }
                            else { a[e] = (l0[e] == 0.f) ? la : __logf(l0[e] + (1.f - l0[e]) * __expf(la));
                                   b[e] = (l1[e] == 0.f) ? lc : __logf(l1[e] + (1.f - l1[e]) * __expf(lc)); }
                        }
                        *(u32x4*)(LF + (size_t)row * 768 + col) = pack8h(a, b); }
                } else if (t < 9) {
#pragma unroll
                    for (int bj = 0; bj < 2; ++bj) *(u32x4*)(VB + (size_t)row * 768 + (t - 6) * 256 + bj * 128 + c8) = pack8(z[bj][0], z[bj][1]);
                } else if (t < 12) {
#pragma unroll
                    for (int bj = 0; bj < 2; ++bj) { f32x4 a = z[bj][0], b = z[bj][1];
#pragma unroll
                        for (int e = 0; e < 4; ++e) { a[e] = silu_f(a[e]); b[e] = silu_f(b[e]); }
                        *(u32x4*)(MIX + (size_t)row * 1024 + (t - 9) * 256 + bj * 128 + c8) = pack8(a, b); }
                } else {
                    headnorm_store(z, gv, QSCALE, MIX + (size_t)row * 1024 + 768 + 64 * wc, fq);
                }
            }
    }
};
struct EpiInB {
    static constexpr bool PERM = true, AFTER_DRAIN = false;
    const float* ssq; bf16_t* QB; bf16_t* MIX; const float* fqgain; const float* mqgain;
    DI void operator()(f32x4 (&acc)[2][2][4][2], const Unit& u, int wr, int wc, int fr, int fq) const {
        const int t = u.pn, row0 = u.pm * 256 + wr * 64 + fr, c8 = wc * 32 + 8 * fq;
        EPI_ROW_RSTD(ssq)
        if (t < 3 || t == 6) {
            EPI_LOAD_GAIN(gv, (t < 3) ? fqgain : mqgain)
#pragma unroll
            for (int ai = 0; ai < 2; ++ai)
#pragma unroll
                for (int m = 0; m < 4; ++m) { const int row = row0 + ai * 128 + m * 16; EPI_Z()
                    headnorm_store(z, gv, QSCALE, (t < 3) ? QB + (size_t)row * 768 + t * 256 + 64 * wc : MIX + (size_t)row * 1024 + 768 + 64 * wc, fq); }
        } else {
#pragma unroll
            for (int ai = 0; ai < 2; ++ai)
#pragma unroll
                for (int m = 0; m < 4; ++m) { const int row = row0 + ai * 128 + m * 16; EPI_Z()
#pragma unroll
                    for (int bj = 0; bj < 2; ++bj) { f32x4 a = z[bj][0], b = z[bj][1];
#pragma unroll
                        for (int e = 0; e < 4; ++e) { a[e] = sigm_f(a[e]); b[e] = sigm_f(b[e]); }
                        *(u32x4*)(MIX + (size_t)row * 1024 + (t - 3) * 256 + bj * 128 + c8) = pack8(a, b); } }
        }
    }
};
struct EpiKV {
    static constexpr bool PERM = true, AFTER_DRAIN = false;
    const float* ssq; bf16_t* KSH; bf16_t* VSH; float* LFX; const float* kgain; const float* fbias;
    DI void operator()(f32x4 (&acc)[2][2][4][2], const Unit& u, int wr, int wc, int fr, int fq) const {
        const int t = u.pn, row0 = u.pm * 256 + wr * 64 + fr, c8 = wc * 32 + 8 * fq;
        EPI_ROW_RSTD(ssq)
        if (t < 3) {
            EPI_LOAD_GAIN(gv, kgain)
#pragma unroll
            for (int ai = 0; ai < 2; ++ai)
#pragma unroll
                for (int m = 0; m < 4; ++m) { const int row = row0 + ai * 128 + m * 16; EPI_Z()
                    headnorm_store(z, gv, 1.0f, KSH + (size_t)row * 768 + t * 256 + 64 * wc, fq); }
        } else if (t < 6) {
#pragma unroll
            for (int ai = 0; ai < 2; ++ai)
#pragma unroll
                for (int m = 0; m < 4; ++m) { const int row = row0 + ai * 128 + m * 16; EPI_Z()
#pragma unroll
                    for (int bj = 0; bj < 2; ++bj) *(u32x4*)(VSH + (size_t)row * 768 + (t - 3) * 256 + bj * 128 + c8) = pack8(z[bj][0], z[bj][1]); }
        } else if (wc == 0 && fq < 2) {
            float fb[2][4];
#pragma unroll
            for (int n = 0; n < 2; ++n)
#pragma unroll
                for (int e = 0; e < 4; ++e) { const int hh = 8 * fq + 4 * n + e; fb[n][e] = (hh < 12) ? fbias[hh] : 0.f; }
#pragma unroll
            for (int ai = 0; ai < 2; ++ai)
#pragma unroll
                for (int m = 0; m < 4; ++m) { const int row = row0 + ai * 128 + m * 16; EPI_Z()
                    const int b = row >> 11, sq = row & 2047;
#pragma unroll
                    for (int n = 0; n < 2; ++n)
#pragma unroll
                        for (int e = 0; e < 4; ++e) { const int hh = 8 * fq + 4 * n + e;
                            if (hh < 12) LFX[(size_t)(b * 12 + hh) * 2048 + sq] = logsig_f(z[0][n][e] + fb[n][e]); } }
        }
    }
};
struct EpiMemKV {
    static constexpr bool PERM = true, AFTER_DRAIN = false;
    const float* ssqm; bf16_t* MK; bf16_t* MV; const float* kgain_all;
    DI void operator()(f32x4 (&acc)[2][2][4][2], const Unit& u, int wr, int wc, int fr, int fq) const {
        const int l = u.pn >> 1, isv = u.pn & 1, row0 = u.pm * 256 + wr * 64 + fr, c8 = wc * 32 + 8 * fq;
        float rs[2][4];
#pragma unroll
        for (int ai = 0; ai < 2; ++ai)
#pragma unroll
            for (int m = 0; m < 4; ++m) rs[ai][m] = rsqrtf(ssqm[row0 + ai * 128 + m * 16] * (1.f / DM) + EPS);
        EPI_LOAD_GAIN(gv, kgain_all + 64 * l)
#pragma unroll
        for (int ai = 0; ai < 2; ++ai)
#pragma unroll
            for (int m = 0; m < 4; ++m) { const int row = row0 + ai * 128 + m * 16; EPI_Z()
                if (!isv) headnorm_store(z, gv, 1.0f, MK + ((size_t)l * MMEM + row) * 256 + 64 * wc, fq);
                else {
#pragma unroll
                    for (int bj = 0; bj < 2; ++bj) *(u32x4*)(MV + ((size_t)l * MMEM + row) * 256 + bj * 128 + c8) = pack8(z[bj][0], z[bj][1]); } }
    }
};

struct OneUnit {
    int pm;
    DI bool next(int i, Unit& u) const { if (i) return false; u.pm = pm; u.pn = 0; return true; }
    DI void a_ready(const Unit&) const {}
    DI void done(const Unit&) const {}
};
enum { MODE_NAT = 0, MODE_GU = 1, MODE_INA = 2, MODE_INB = 3, MODE_KV = 4, MODE_MEMKV = 5 };
DI void map_blk(int mode, int blk, int& scol, int& nvalid, int& which) {
    nvalid = 32; which = 0;
    const int tile = blk >> 3, j = blk & 7, pj = 64 * (j & 3) + 32 * (j >> 2);
    switch (mode) {
        case MODE_GU: which = j >> 2; scol = 128 * tile + 32 * (j & 3); break;
        case MODE_INA: scol = (tile == 12) ? 256 * tile + pj : 32 * blk; break;
        case MODE_INB: scol = (tile <= 2 || tile == 6) ? 256 * tile + pj : 32 * blk; break;
        case MODE_KV: if (tile <= 2) scol = 256 * tile + pj; else if (tile <= 5) scol = 32 * blk; else { scol = 1536; nvalid = (j == 0) ? 12 : 0; } break;
        case MODE_MEMKV: scol = (tile == 0) ? pj : 32 * blk; break;
        default: scol = 32 * blk; break;
    }
}
DI void conv_item(const float* W, int ldw, int K, bf16_t* WT, int dst_row0, int src_col0, int nvalid, const float* gain, int k0, LAS float* scr, int lane) {
    if (nvalid == 32) {
        const int kk0 = lane >> 3, n4 = lane & 7;
        f32x4 v[8];
#pragma unroll
        for (int i = 0; i < 8; ++i) v[i] = *(const f32x4*)(W + (size_t)(k0 + kk0 + 8 * i) * ldw + src_col0 + 4 * n4);
#pragma unroll
        for (int i = 0; i < 8; ++i) { LAS float* d = scr + (kk0 + 8 * i) * 33 + 4 * n4; d[0] = v[i][0]; d[1] = v[i][1]; d[2] = v[i][2]; d[3] = v[i][3]; }
    } else {
        const int c = lane & 31;
#pragma unroll 8
        for (int i = 0; i < 32; ++i) { const int kk = 2 * i + (lane >> 5);
            scr[kk * 33 + c] = (c < nvalid) ? W[(size_t)(k0 + kk) * ldw + src_col0 + c] : 0.f; }
    }
    asm volatile("s_waitcnt lgkmcnt(0)" ::: "memory");
    const int c8 = lane & 7;
    f32x4 g0 = (f32x4){1.f, 1.f, 1.f, 1.f}, g1 = g0;
    if (gain) { g0 = *(const f32x4*)(gain + k0 + 8 * c8); g1 = *(const f32x4*)(gain + k0 + 8 * c8 + 4); }
#pragma unroll
    for (int j = 0; j < 4; ++j) { const int n = (lane >> 3) + 8 * j; const LAS float* s = scr + (8 * c8) * 33 + n;
        u32x4 o; o.x = pk2(s[0 * 33] * g0[0], s[1 * 33] * g0[1]); o.y = pk2(s[2 * 33] * g0[2], s[3 * 33] * g0[3]); o.z = pk2(s[4 * 33] * g1[0], s[5 * 33] * g1[1]); o.w = pk2(s[6 * 33] * g1[2], s[7 * 33] * g1[3]);
        *(u32x4*)(WT + (size_t)(dst_row0 + n) * K + k0 + 8 * c8) = o; }
    asm volatile("s_waitcnt lgkmcnt(0)" ::: "memory");
}
DI void conv_job(int mode, const float* src, const float* src2, int ldw, int K, bf16_t* dst, int ndblk, const float* gain, int& base, int gw, int NGW, LAS float* scr, int lane) {
    const int nitems = ndblk * (K / 64);
    int it = gw - (base % NGW); if (it < 0) it += NGW;
    for (; it < nitems; it += NGW) {
        const int kb = it / ndblk, nb = it - kb * ndblk; int scol, nvalid, which;
        map_blk(mode, nb, scol, nvalid, which);
        conv_item(which ? src2 : src, ldw, K, dst, nb * 32, scol, nvalid, gain, kb * 64, scr, lane);
    }
    base += nitems;
}
DI void row_to_bf16(const float* xrow, bf16_t* orow, float* ssq1, int lane, bool slots) {
    const f32x4* xr = (const f32x4*)xrow + lane; f32x4 v[4]; float s = 0.f;
#pragma unroll
    for (int j = 0; j < 4; ++j) { v[j] = xr[64 * j]; s += (v[j][0] * v[j][0] + v[j][1] * v[j][1]) + (v[j][2] * v[j][2] + v[j][3] * v[j][3]); }
    s = wave_sum(s);
    u32x2* o8 = (u32x2*)orow + lane;
#pragma unroll
    for (int j = 0; j < 4; ++j) { u32x2 o; o.x = pk2(v[j][0], v[j][1]); o.y = pk2(v[j][2], v[j][3]); o8[64 * j] = o; }
    if (slots) { if (lane < 16) ssq1[lane] = lane ? 0.f : s; } else if (lane == 0) *ssq1 = s;
}


DI void conv_layer(const Params& p, unsigned char* ws, int l, int& base, int gw, int NGW, LAS float* scr, int lane) {
    conv_job(MODE_GU, p.in[3] + (size_t)l * DM * DFF, p.in[4] + (size_t)l * DM * DFF, DFF, DM, (bf16_t*)(ws + O_WGU1 + l * SZ_WGU), NGU / 32, p.in[2] + l * DM, base, gw, NGW, scr, lane);
    conv_job(MODE_NAT, p.in[5] + (size_t)l * DFF * DM, nullptr, DM, DFF, (bf16_t*)(ws + O_WD1 + l * SZ_WD), DM / 32, nullptr, base, gw, NGW, scr, lane);
    conv_job(MODE_GU, p.in[22] + (size_t)l * DM * DFF, p.in[23] + (size_t)l * DM * DFF, DFF, DM, (bf16_t*)(ws + O_WGU2 + l * SZ_WGU), NGU / 32, p.in[21] + l * DM, base, gw, NGW, scr, lane);
    conv_job(MODE_NAT, p.in[24] + (size_t)l * DFF * DM, nullptr, DM, DFF, (bf16_t*)(ws + O_WD2 + l * SZ_WD), DM / 32, nullptr, base, gw, NGW, scr, lane);
    conv_job(MODE_NAT, p.in[20] + (size_t)l * DM * DM, nullptr, DM, DM, (bf16_t*)(ws + O_WOUT + l * SZ_WOUT), DM / 32, nullptr, base, gw, NGW, scr, lane);
    if (l < 2) conv_job(MODE_INA, p.in[11] + (size_t)l * DM * NINA, nullptr, NINA, DM, (bf16_t*)(ws + O_WINA + l * SZ_WINA), NINA / 32, p.in[6] + l * DM, base, gw, NGW, scr, lane);
    else conv_job(MODE_INB, p.in[14] + (size_t)(l - 2) * DM * NINB, nullptr, NINB, DM, (bf16_t*)(ws + O_WINB + (l - 2) * SZ_WINB), NINB / 32, p.in[6] + l * DM, base, gw, NGW, scr, lane);
}
DI void hgrn_chain(const bf16_t* __restrict__ QB, const bf16_t* __restrict__ LF, const bf16_t* __restrict__ VB, const bf16_t* MIXG, bf16_t* MIX, const float* __restrict__ ogain, int b, int h, LAS unsigned char* lds) {
    int tid = threadIdx.x; asm volatile("" : "+v"(tid)); const int lane = tid & 63, w = __builtin_amdgcn_readfirstlane(tid >> 6), l15 = lane & 15, quad = lane >> 4;
    LAS bf16_t* QM = (LAS bf16_t*)lds; LAS bf16_t* KM = QM + 64 * 136; LAS bf16_t* QC = KM + 64 * 136; LAS bf16_t* KEt = QC + 64 * 136;
    LAS bf16_t* Vt = KEt + 128 * 72; LAS bf16_t* Pm = Vt + 128 * 72; LAS bf16_t* Sb = Pm + 64 * 72;
    LAS float* tot = (LAS float*)(Sb + 128 * 136); LAS float* cend = tot + 1024; LAS float* rss = cend + 128;
    for (int i = tid; i < 128 * 136 / 2; i += NTHREADS) ((LAS unsigned*)Sb)[i] = 0u;
    f32x4 S[8];
#pragma unroll
    for (int i = 0; i < 8; ++i) S[i] = (f32x4){0.f, 0.f, 0.f, 0.f};
    const size_t rowbase = (size_t)b * SEQ; const int hc = h * 128;
    const int tp = tid & 31, dvg = tid >> 5;
    unsigned lfr[8]; unsigned qv[8]; u32x4 vv0, vv1;
#define HG_LOAD(n_) do { const size_t r0_ = rowbase + (size_t)(n_) * 64; \
        _Pragma("unroll") for (int i = 0; i < 8; ++i) { const size_t r_ = r0_ + 8 * w + i; lfr[i] = *(const unsigned*)(LF + r_ * 768 + hc + 2 * lane); qv[i] = *(const unsigned*)(QB + r_ * 768 + hc + 2 * lane); } \
        vv0 = *(const u32x4*)(VB + (r0_ + 2 * tp) * 768 + hc + 8 * dvg); vv1 = *(const u32x4*)(VB + (r0_ + 2 * tp + 1) * 768 + hc + 8 * dvg); } while (0)
    HG_LOAD(0);
    for (int n = 0; n < 32; ++n) {
        const int tt = w >> 1, dh = w & 1;
        const size_t r0 = rowbase + (size_t)n * 64;
        bf16_t gq[4][4];
#pragma unroll
        for (int i = 0; i < 4; ++i)
#pragma unroll
            for (int j = 0; j < 4; ++j) gq[i][j] = MIXG[(r0 + 16 * tt + 4 * quad + j) * 1024 + hc + 64 * dh + 16 * i + l15];
        float cx[8], cy[8]; float sx = 0.f, sy = 0.f; f32x2 lf[8];
#pragma unroll
        for (int i = 0; i < 8; ++i) lf[i] = (f32x2){hlo(lfr[i]), hhi(lfr[i])};
#pragma unroll
        for (int i = 0; i < 8; ++i) { sx += lf[i].x; sy += lf[i].y; cx[i] = sx; cy[i] = sy; }
        *(LAS f32x2*)(tot + w * 128 + 2 * lane) = (f32x2){sx, sy};
        __syncthreads();
        float bx = 0.f, by = 0.f, mx = 0.f, my = 0.f, ex = 0.f, ey = 0.f;
#pragma unroll
        for (int g = 0; g < 8; ++g) { const f32x2 t2 = *(const LAS f32x2*)(tot + g * 128 + 2 * lane);
            if (g < w) { bx += t2.x; by += t2.y; } if (g < 4) { mx += t2.x; my += t2.y; } ex += t2.x; ey += t2.y; }
        if (w == 0) *(LAS f32x2*)(cend + 2 * lane) = (f32x2){ex, ey};
        float kex[8], key[8];
        const float emX = __expf(mx), emY = __expf(my), eeX = __expf(ex - mx), eeY = __expf(ey - my);
#pragma unroll
        for (int i = 0; i < 8; ++i) {
            const float cX = bx + cx[i], cY = by + cy[i];
            const float kX = 1.f - __expf(lf[i].x), kY = 1.f - __expf(lf[i].y);
            const float qX = bflo(qv[i]), qY = bfhi(qv[i]);
            const float dX = fminf(fmaxf(cX - mx, -80.f), 80.f), dY = fminf(fmaxf(cY - my, -80.f), 80.f);
            const int t = 8 * w + i;
            const float e1X = __expf(dX), e1Y = __expf(dY), e2X = __builtin_amdgcn_rcpf(e1X), e2Y = __builtin_amdgcn_rcpf(e1Y);
            const float qmX = qX * e1X, qmY = qY * e1Y, kmX = kX * e2X, kmY = kY * e2Y;
            *(LAS unsigned*)(QM + t * 136 + 2 * lane) = pk2(qmX, qmY);
            *(LAS unsigned*)(KM + t * 136 + 2 * lane) = pk2(kmX, kmY);
            *(LAS unsigned*)(QC + t * 136 + 2 * lane) = pk2(qmX * emX, qmY * emY);
            kex[i] = kmX * eeX; key[i] = kmY * eeY;
        }
        { u32x4 a, c2; a.x = pk2(kex[0], kex[1]); a.y = pk2(kex[2], kex[3]); a.z = pk2(kex[4], kex[5]); a.w = pk2(kex[6], kex[7]);
          c2.x = pk2(key[0], key[1]); c2.y = pk2(key[2], key[3]); c2.z = pk2(key[4], key[5]); c2.w = pk2(key[6], key[7]);
          *(LAS u32x4*)(KEt + (2 * lane) * 72 + 8 * w) = a; *(LAS u32x4*)(KEt + (2 * lane + 1) * 72 + 8 * w) = c2; }
#pragma unroll
        for (int i = 0; i < 8; ++i) { const unsigned a = vv0[i >> 1], c2 = vv1[i >> 1];
            const unsigned lo = (i & 1) ? (a >> 16) : (a & 0xffffu), hi = (i & 1) ? (c2 >> 16) : (c2 & 0xffffu);
            *(LAS unsigned*)(Vt + (8 * dvg + i) * 72 + 2 * tp) = lo | (hi << 16); }
        if (n + 1 < 32) HG_LOAD(n + 1);
        __syncthreads();
#pragma unroll
        for (int q = 0; q < 2; ++q) { const int idx = 2 * w + q, si = idx >> 2, ti = idx & 3;
            f32x4 a4 = (f32x4){0.f, 0.f, 0.f, 0.f};
            if (si <= ti) {
                bf16x8 ca[4], cb[4];
#pragma unroll
                for (int ks = 0; ks < 4; ++ks) { ca[ks] = *(const LAS bf16x8*)(KM + (16 * si + l15) * 136 + 32 * ks + 8 * quad); cb[ks] = *(const LAS bf16x8*)(QM + (16 * ti + l15) * 136 + 32 * ks + 8 * quad); }
__builtin_amdgcn_sched_barrier(0);
#pragma unroll
                for (int ks = 0; ks < 4; ++ks) a4 = MFMA16(ca[ks], cb[ks], a4);
                if (si == ti) {
#pragma unroll
                    for (int j = 0; j < 4; ++j) if (4 * quad + j > l15) a4[j] = 0.f; }
            }
            u32x2 pw; pw.x = pk2(a4[0], a4[1]); pw.y = pk2(a4[2], a4[3]);
            *(LAS u32x2*)(Pm + (16 * ti + l15) * 72 + 16 * si + 4 * quad) = pw; }
        __syncthreads();
        f32x4 o[4];
        { bf16x8 ap[2], aq[4];
#pragma unroll
          for (int ks = 0; ks < 2; ++ks) ap[ks] = *(const LAS bf16x8*)(Pm + (16 * tt + l15) * 72 + 32 * ks + 8 * quad);
#pragma unroll
          for (int ks = 0; ks < 4; ++ks) aq[ks] = *(const LAS bf16x8*)(QC + (16 * tt + l15) * 136 + 32 * ks + 8 * quad);
          bf16x8 bv[4][2], bs[4][4];
#pragma unroll
          for (int i = 0; i < 4; ++i) { const int dvr = 64 * dh + 16 * i + l15;
#pragma unroll
              for (int ks = 0; ks < 2; ++ks) bv[i][ks] = *(const LAS bf16x8*)(Vt + dvr * 72 + 32 * ks + 8 * quad);
#pragma unroll
              for (int ks = 0; ks < 4; ++ks) bs[i][ks] = *(const LAS bf16x8*)(Sb + dvr * 136 + 32 * ks + 8 * quad); }
#pragma unroll
          for (int i = 0; i < 4; ++i) o[i] = (f32x4){0.f, 0.f, 0.f, 0.f};
          __builtin_amdgcn_sched_barrier(0);
#pragma unroll
          for (int ks = 0; ks < 2; ++ks)
#pragma unroll
              for (int i = 0; i < 4; ++i) o[i] = MFMA16(ap[ks], bv[i][ks], o[i]);
#pragma unroll
          for (int ks = 0; ks < 4; ++ks)
#pragma unroll
              for (int i = 0; i < 4; ++i) o[i] = MFMA16(aq[ks], bs[i][ks], o[i]); }
        { f32x4 ss = o[0] * o[0] + o[1] * o[1] + o[2] * o[2] + o[3] * o[3];
#pragma unroll
          for (int j = 0; j < 4; ++j) { float v = ss[j]; v += __shfl_xor(v, 1); v += __shfl_xor(v, 2); v += __shfl_xor(v, 4); v += __shfl_xor(v, 8);
              if (l15 == 0) rss[(16 * tt + 4 * quad + j) * 2 + dh] = v; } }
        { bf16x8 ak[2];
#pragma unroll
          for (int ks = 0; ks < 2; ++ks) ak[ks] = *(const LAS bf16x8*)(KEt + (16 * w + l15) * 72 + 32 * ks + 8 * quad);
          f32x4 dec = *(const LAS f32x4*)(cend + 16 * w + 4 * quad);
#pragma unroll
          for (int j = 0; j < 4; ++j) dec[j] = __expf(dec[j]);
          bf16x8 ev[8][2];
#pragma unroll
          for (int dt = 0; dt < 8; ++dt)
#pragma unroll
              for (int ks = 0; ks < 2; ++ks) ev[dt][ks] = *(const LAS bf16x8*)(Vt + (16 * dt + l15) * 72 + 32 * ks + 8 * quad);
#pragma unroll
          for (int dt = 0; dt < 8; ++dt) S[dt] = S[dt] * dec;
          __builtin_amdgcn_sched_barrier(0);
#pragma unroll
          for (int ks = 0; ks < 2; ++ks)
#pragma unroll
              for (int dt = 0; dt < 8; ++dt) S[dt] = MFMA16(ak[ks], ev[dt][ks], S[dt]); }
        __syncthreads();
        float rsn[4];
#pragma unroll
        for (int j = 0; j < 4; ++j) { const f32x2 r2 = *(const LAS f32x2*)(rss + 2 * (16 * tt + 4 * quad + j)); rsn[j] = rsqrtf((r2.x + r2.y) * (1.f / 128.f) + EPS); }
#pragma unroll
        for (int i = 0; i < 4; ++i) { const float og = ogain[64 * dh + 16 * i + l15];
#pragma unroll
            for (int j = 0; j < 4; ++j) { const float val = o[i][j] * rsn[j] * og * bf1(gq[i][j]);
                MIX[(r0 + 16 * tt + 4 * quad + j) * 1024 + hc + 64 * dh + 16 * i + l15] = (bf16_t)(pk2(val, 0.f) & 0xffffu); } }
#pragma unroll
        for (int dt = 0; dt < 8; ++dt) { u32x2 sw; sw.x = pk2(S[dt][0], S[dt][1]); sw.y = pk2(S[dt][2], S[dt][3]);
            *(LAS u32x2*)(Sb + (16 * dt + l15) * 136 + 16 * w + 4 * quad) = sw; }
    }
#undef HG_LOAD
    __syncthreads();
}

DI void attn_item(const bf16_t* Qp, int ldq, const bf16_t* __restrict__ Kp, const bf16_t* __restrict__ Vp, int ldkv, int nkv, const float* __restrict__ bias, int q0, bool causal,
                  const bf16_t* Gp, bf16_t* Op, int ldo, bool gated, LAS unsigned char* lds) {
    int tid = threadIdx.x; asm volatile("" : "+v"(tid)); const int lane = tid & 63, w = __builtin_amdgcn_readfirstlane(tid >> 6), l15 = lane & 15, quad = lane >> 4;
    constexpr int ABUF = 64 * 72 * 2 * 2 + 256;
    bf16x8 bq[2][2];
#pragma unroll
    for (int qt = 0; qt < 2; ++qt)
#pragma unroll
        for (int ks = 0; ks < 2; ++ks) bq[qt][ks] = *(const bf16x8*)(Qp + (size_t)(32 * w + 16 * qt + l15) * ldq + 32 * ks + 8 * quad);
    const float dref = bias ? bias[q0] : 0.f;
    float mrun[2] = {-INFINITY, -INFINITY}, lsum[2] = {0.f, 0.f};
    f32x4 o[2][4];
#pragma unroll
    for (int qt = 0; qt < 2; ++qt)
#pragma unroll
        for (int dt = 0; dt < 4; ++dt) o[qt][dt] = (f32x4){0.f, 0.f, 0.f, 0.f};
    const int key_l = tid >> 3, ch = tid & 7, kp = tid >> 4, dvg = tid & 15;
    u32x4 kreg; u32x2 v0, v1; float breg = 0.f;
#define AT_LOAD(kt_) do { const size_t kr_ = (size_t)(kt_) * 64; kreg = *(const u32x4*)(Kp + (kr_ + key_l) * ldkv + 8 * ch); \
        v0 = *(const u32x2*)(Vp + (kr_ + 2 * kp) * ldkv + 4 * dvg); v1 = *(const u32x2*)(Vp + (kr_ + 2 * kp + 1) * ldkv + 4 * dvg); \
        if (tid < 64) breg = bias ? (dref - bias[kr_ + tid]) : 0.f; } while (0)
#define AT_STORE(buf_) do { LAS bf16_t* Ks_ = (LAS bf16_t*)(lds + (buf_) * ABUF); LAS bf16_t* Vt_ = Ks_ + 64 * 72; LAS float* bl_ = (LAS float*)(Vt_ + 64 * 72); \
        *(LAS u32x4*)(Ks_ + key_l * 72 + 8 * ch) = kreg; \
        _Pragma("unroll") for (int i = 0; i < 4; ++i) { const unsigned a = v0[i >> 1], c2 = v1[i >> 1]; \
            const unsigned lo = (i & 1) ? (a >> 16) : (a & 0xffffu), hi = (i & 1) ? (c2 >> 16) : (c2 & 0xffffu); \
            *(LAS unsigned*)(Vt_ + (4 * dvg + i) * 72 + 2 * kp) = lo | (hi << 16); } \
        if (tid < 64) bl_[tid] = breg; } while (0)
    AT_LOAD(0);
    const int qlo = q0 + 32 * w;
    AT_STORE(0);
    __syncthreads();
    for (int kt = 0; kt < nkv; ++kt) {
        if (kt) { AT_STORE(kt & 1); __syncthreads(); }
        if (kt + 1 < nkv) AT_LOAD(kt + 1);
        if (causal && 64 * kt > qlo + 31) continue;
        const LAS bf16_t* Ks = (const LAS bf16_t*)(lds + (kt & 1) * ABUF); const LAS bf16_t* Vt = Ks + 64 * 72; const LAS float* bl = (const LAS float*)(Vt + 64 * 72);
        f32x4 s[2][4];
        { bf16x8 ka[4][2]; f32x4 kb[4];
#pragma unroll
          for (int ky = 0; ky < 4; ++ky) { ka[ky][0] = *(const LAS bf16x8*)(Ks + (16 * ky + l15) * 72 + 8 * quad); ka[ky][1] = *(const LAS bf16x8*)(Ks + (16 * ky + l15) * 72 + 32 + 8 * quad);
              kb[ky] = *(const LAS f32x4*)(bl + 16 * ky + 4 * quad); }
          __builtin_amdgcn_sched_barrier(0);
#pragma unroll
          for (int ky = 0; ky < 4; ++ky)
#pragma unroll
              for (int qt = 0; qt < 2; ++qt) s[qt][ky] = MFMA16(ka[ky][0], bq[qt][0], kb[ky]);
#pragma unroll
          for (int ky = 0; ky < 4; ++ky)
#pragma unroll
              for (int qt = 0; qt < 2; ++qt) s[qt][ky] = MFMA16(ka[ky][1], bq[qt][1], s[qt][ky]); }
        if (causal && 64 * kt + 63 > qlo) {
#pragma unroll
            for (int qt = 0; qt < 2; ++qt)
#pragma unroll
                for (int ky = 0; ky < 4; ++ky)
#pragma unroll
                    for (int j = 0; j < 4; ++j) if (64 * kt + 16 * ky + 4 * quad + j > qlo + 16 * qt + l15) s[qt][ky][j] = -INFINITY;
        }
#pragma unroll
        for (int qt = 0; qt < 2; ++qt) {
            float tm = -INFINITY;
#pragma unroll
            for (int ky = 0; ky < 4; ++ky) tm = fmaxf(tm, fmaxf(fmaxf(s[qt][ky][0], s[qt][ky][1]), fmaxf(s[qt][ky][2], s[qt][ky][3])));
            tm = fmaxf(tm, __shfl_xor(tm, 16)); tm = fmaxf(tm, __shfl_xor(tm, 32));
            const float mn = fmaxf(mrun[qt], tm);
            const float alpha = __builtin_amdgcn_exp2f(mrun[qt] - mn);
            mrun[qt] = mn; float ps = 0.f;
#pragma unroll
            for (int ky = 0; ky < 4; ++ky)
#pragma unroll
                for (int j = 0; j < 4; ++j) { const float pv = __builtin_amdgcn_exp2f(s[qt][ky][j] - mn); s[qt][ky][j] = pv; ps += pv; }
            lsum[qt] = lsum[qt] * alpha + ps;
#pragma unroll
            for (int dt = 0; dt < 4; ++dt) o[qt][dt] *= alpha;
        }
#pragma unroll
        for (int ks2 = 0; ks2 < 2; ++ks2) {
            bf16x8 pb[2];
#pragma unroll
            for (int qt = 0; qt < 2; ++qt) { u32x4 pw; pw.x = pk2(s[qt][2 * ks2][0], s[qt][2 * ks2][1]); pw.y = pk2(s[qt][2 * ks2][2], s[qt][2 * ks2][3]);
                pw.z = pk2(s[qt][2 * ks2 + 1][0], s[qt][2 * ks2 + 1][1]); pw.w = pk2(s[qt][2 * ks2 + 1][2], s[qt][2 * ks2 + 1][3]); pb[qt] = __builtin_bit_cast(bf16x8, pw); }
            bf16x8 va[4];
#pragma unroll
            for (int dt = 0; dt < 4; ++dt) { const u32x2 lo = *(const LAS u32x2*)(Vt + (16 * dt + l15) * 72 + 32 * ks2 + 4 * quad), hi = *(const LAS u32x2*)(Vt + (16 * dt + l15) * 72 + 32 * ks2 + 16 + 4 * quad);
                u32x4 av; av.x = lo.x; av.y = lo.y; av.z = hi.x; av.w = hi.y; va[dt] = __builtin_bit_cast(bf16x8, av); }
            __builtin_amdgcn_sched_barrier(0);
#pragma unroll
            for (int dt = 0; dt < 4; ++dt)
#pragma unroll
                for (int qt = 0; qt < 2; ++qt) o[qt][dt] = MFMA16(va[dt], pb[qt], o[qt][dt]);
        }
    }
#undef AT_LOAD
#undef AT_STORE
#pragma unroll
    for (int qt = 0; qt < 2; ++qt) {
        float l = lsum[qt]; l += __shfl_xor(l, 16); l += __shfl_xor(l, 32);
        const float inv = 1.f / l;
        bf16_t* orow = Op + (size_t)(32 * w + 16 * qt + l15) * ldo + 4 * quad; const bf16_t* grow = Gp + (size_t)(32 * w + 16 * qt + l15) * ldo + 4 * quad;
#pragma unroll
        for (int dt = 0; dt < 4; ++dt) { f32x4 v = o[qt][dt] * inv;
            if (gated) { const u32x2 g = *(const u32x2*)(grow + 16 * dt); v[0] *= bflo(g.x); v[1] *= bfhi(g.x); v[2] *= bflo(g.y); v[3] *= bfhi(g.y); }
            u32x2 ow; ow.x = pk2(v[0], v[1]); ow.y = pk2(v[2], v[3]); *(u32x2*)(orow + 16 * dt) = ow; }
    }
    __syncthreads();
}
DI void fox_cumsum(const float* LFX, float* DL, int bh, int lane) {
    const float* src = LFX + (size_t)bh * 2048 + 32 * lane; float v[32]; float s = 0.f;
#pragma unroll
    for (int i = 0; i < 8; ++i) { const f32x4 t = *(const f32x4*)(src + 4 * i);
#pragma unroll
        for (int e = 0; e < 4; ++e) { s += t[e]; v[4 * i + e] = s; } }
    float incl = s;
#pragma unroll
    for (int off = 1; off < 64; off <<= 1) { const float t = __shfl_up(incl, off); if (lane >= off) incl += t; }
    const float excl = incl - s;
    float* dst = DL + (size_t)bh * 2048 + 32 * lane;
#pragma unroll
    for (int i = 0; i < 8; ++i) { f32x4 t;
#pragma unroll
        for (int e = 0; e < 4; ++e) t[e] = (v[4 * i + e] + excl) * LOG2E;
        *(f32x4*)(dst + 4 * i) = t; }
}
DI void mem_attn_item(int j, int l, bf16_t* MIX, const bf16_t* MK, const bf16_t* MV, LAS unsigned char* lds) {
    const int b = j >> 5, qb = (j >> 2) & 7, hd = j & 3;
    bf16_t* qo = MIX + ((size_t)b * SEQ + 256 * qb) * 1024 + 768 + 64 * hd;
    const size_t kvoff = ((size_t)l * MMEM + (size_t)b * NMEMT) * 256 + 64 * hd;
    attn_item(qo, 1024, MK + kvoff, MV + kvoff, 256, 4, nullptr, 0, false, qo, qo, 1024, false, lds);
}


typedef unsigned v4u __attribute__((ext_vector_type(4)));
#define XB_TMO      128
#define XB_XCNT(j)  (256  + 64 * (j))
#define XB_XSUB(j)  (1280 + 64 * (j))
#define XB_XGEN(j)  (2304 + 64 * (j))
#define XB_TOP      3328
#define XB_TOPGEN   3392
#define XCD_BAR_WORDS 3456
#define XB_SPIN_CAP (1u << 18)

__device__ __forceinline__ unsigned xb_ld(unsigned* p)              { return __hip_atomic_load(p, __ATOMIC_RELAXED, __HIP_MEMORY_SCOPE_AGENT); }
__device__ __forceinline__ unsigned xb_add(unsigned* p, unsigned v) { return __hip_atomic_fetch_add(p, v, __ATOMIC_RELAXED, __HIP_MEMORY_SCOPE_AGENT); }
__device__ __forceinline__ unsigned xb_xcc_id() { return (unsigned)__builtin_amdgcn_s_getreg((3 << 11) | 20) & 0xFu; }
#define XB_SPIN(cond, bar) do { unsigned _sp = 0; while (cond) { __builtin_amdgcn_s_sleep(12);   \
    if ((++_sp & 255u) == 0u) { if (xb_ld(&(bar)[XB_TMO])) break; if (_sp > XB_SPIN_CAP) { atomicAdd(&(bar)[XB_TMO], 1u); break; } } } } while (0)

struct XcdBarrier {
    unsigned* bar; unsigned x;
    volatile LAS unsigned* st;
};

__device__ __forceinline__ XcdBarrier xcd_barrier_post(unsigned* bar, volatile LAS unsigned* st) {
    XcdBarrier b; b.bar = bar; b.x = xb_xcc_id(); b.st = st;
    if (threadIdx.x == 0) (void)xb_add(&bar[XB_XCNT(b.x)], 1u);
    return b;
}
__device__ __forceinline__ void xcd_barrier_complete(unsigned* bar, unsigned x, unsigned& nloc, unsigned& nx) {
    const unsigned G = gridDim.x * gridDim.y * gridDim.z;
    unsigned sum, cnt, mine, sp = 0u;
    for (;;) {
        sum = 0u; cnt = 0u; mine = 0u;
#pragma unroll
        for (unsigned j = 0; j < 16; ++j) { const unsigned c = xb_ld(&bar[XB_XCNT(j)]); sum += c; cnt += (c > 0u) ? 1u : 0u; mine = (j == x) ? c : mine; }
        if (sum == G) break;
        __builtin_amdgcn_s_sleep(1);
        if ((++sp & 255u) == 0u) { if (xb_ld(&bar[XB_TMO])) break; if (sp > XB_SPIN_CAP) { atomicAdd(&bar[XB_TMO], 1u); break; } }
    }
    nloc = mine > 0u ? mine : 1u; nx = cnt > 0u ? cnt : 1u;
}

__device__ __forceinline__ void xcd_barrier(const XcdBarrier& b) {
    asm volatile("s_waitcnt vmcnt(0)" ::: "memory");
    __syncthreads();
    if (threadIdx.x == 0) {
        unsigned* bar = b.bar;
        __builtin_amdgcn_s_waitcnt(0);
        unsigned nloc = b.st[0], nx = b.st[1];
        if (nloc == 0u) { xcd_barrier_complete(bar, b.x, nloc, nx); b.st[0] = nloc; b.st[1] = nx; }
        const unsigned old = xb_add(&bar[XB_XSUB(b.x)], 1u);
        const unsigned gen = old / nloc;
        if (old + 1u == (gen + 1u) * nloc) {
            __builtin_amdgcn_fence(__ATOMIC_RELEASE, "agent");
            asm volatile("s_waitcnt vmcnt(0)" ::: "memory");
            const unsigned og = xb_add(&bar[XB_TOP], 1u);
            const unsigned tg = og / nx;
            if (og + 1u == (tg + 1u) * nx) xb_add(&bar[XB_TOPGEN], 1u);
            else XB_SPIN(xb_ld(&bar[XB_TOPGEN]) == tg, bar);
            __builtin_amdgcn_fence(__ATOMIC_ACQUIRE, "agent");
            xb_add(&bar[XB_XGEN(b.x)], 1u);
            asm volatile("s_waitcnt vmcnt(0)" ::: "memory");
        } else {
            XB_SPIN(xb_ld(&bar[XB_XGEN(b.x)]) == gen, bar);
            __builtin_amdgcn_fence(__ATOMIC_ACQUIRE, "agent");
            asm volatile("s_waitcnt vmcnt(0)" ::: "memory");
        }
    }
    __syncthreads();
}

#define GRID_SYNC0() do { asm volatile("s_waitcnt vmcnt(0)" ::: "memory"); __syncthreads(); grid.sync(); __builtin_amdgcn_fence(__ATOMIC_ACQUIRE, "agent"); asm volatile("s_waitcnt vmcnt(0)" ::: "memory"); __syncthreads(); } while (0)
#define GRID_SYNC() do { XcdBarrier b_; b_.bar = (unsigned*)(wsp(p) + O_BAR); b_.x = xbar_x; asm volatile("" : "+s"(b_.x)); b_.st = (volatile LAS unsigned*)(lds + LDS_BARST); xcd_barrier(b_); } while (0)
DI unsigned char* wsp(const Params& p) { size_t z_ = 0; asm volatile("" : "+s"(z_)); return p.ws + z_; }
#define WSPTRS unsigned char* ws = wsp(p); int L_ = l, H_ = half; asm volatile("" : "+s"(L_), "+s"(H_)); (void)L_; (void)H_; bf16_t* XB = (bf16_t*)(ws + O_XB); bf16_t* ACT = (bf16_t*)(ws + O_ACT); bf16_t* QB = (bf16_t*)(ws + O_QB); bf16_t* LF = (bf16_t*)(ws + O_LF); \
    bf16_t* VB = (bf16_t*)(ws + O_VB); bf16_t* MIX = (bf16_t*)(ws + O_MIX); bf16_t* KSH = (bf16_t*)(ws + O_KSH); bf16_t* VSH = (bf16_t*)(ws + O_VSH); \
    float* LFX = (float*)(ws + O_LFX); float* DL = (float*)(ws + O_DL); bf16_t* MEMB = (bf16_t*)(ws + O_MEMB); bf16_t* MK = (bf16_t*)(ws + O_MK); bf16_t* MV = (bf16_t*)(ws + O_MV); \
    float* SSQ = (float*)(ws + O_SSQ); float* SSQM = (float*)(ws + O_SSQM); float* LBV = (float*)(ws + O_LBV); float* OUT = p.out; \
    (void)XB;(void)ACT;(void)QB;(void)LF;(void)VB;(void)MIX;(void)KSH;(void)VSH;(void)LFX;(void)DL;(void)MEMB;(void)MK;(void)MV;(void)SSQ;(void)SSQM;(void)LBV;(void)OUT;
__global__ void __launch_bounds__(NTHREADS) fwd_kernel(Params p) {
    extern __shared__ __attribute__((aligned(16))) unsigned char lds_raw[];
    LAS unsigned char* lds = (LAS unsigned char*)lds_raw;
    cg::grid_group grid = cg::this_grid();
    const int G = gridDim.x, blk = blockIdx.x, tid = threadIdx.x, lane = tid & 63, w = __builtin_amdgcn_readfirstlane(tid >> 6);

    if (tid < 16) ((LAS unsigned*)(lds + LDS_BARST))[tid] = 0u;
    __syncthreads();
    const unsigned xbar_x = xcd_barrier_post((unsigned*)(p.ws + O_BAR), (volatile LAS unsigned*)(lds + LDS_BARST)).x;
    {   const int l = 0, half = 0; WSPTRS
        LAS float* scr = (LAS float*)(lds + w * 16384);
        const int gw = blk * 8 + w, NGW = G * 8; int base = 0;
        conv_layer(p, ws, 0, base, gw, NGW, scr, lane);
        for (int l2 = 0; l2 < 4; ++l2) conv_job(MODE_MEMKV, p.in[8] + (size_t)l2 * DM * 512, nullptr, 512, DM, (bf16_t*)(ws + O_WMKV) + (size_t)l2 * 512 * DM, 16, p.in[7] + l2 * DM, base, gw, NGW, scr, lane);
        for (int m = gw; m < MTOK; m += NGW) row_to_bf16(p.in[0] + (size_t)m * DM, XB + (size_t)m * DM, SSQ + (size_t)m * 16, lane, true);
        for (int m = gw; m < MMEM; m += NGW) row_to_bf16(p.in[1] + (size_t)m * DM, MEMB + (size_t)m * DM, SSQM + m, lane, false);
        const int gt = blk * NTHREADS + tid;
        if (gt < 768) { LBV[gt] = 0.f; LBV[768 + gt] = 1.f / (1.f + __expf(p.in[12][gt] - p.in[12][768 + gt])); }
    }
    { int never_ = 0; asm volatile("" : "+s"(never_)); if (never_) GRID_SYNC0(); }
    GRID_SYNC();

    for (int l = 0; l < 4; ++l) {
        for (int half = 0; half < 2; ++half) {
            if (l == 2 && half == 0) { int t2 = threadIdx.x; asm volatile("" : "+v"(t2)); if ((t2 >> 6) == 0) { WSPTRS for (int bh = blk; bh < 96; bh += G) fox_cumsum(LFX, DL, bh, t2 & 63); } }
            {
                WSPTRS const bf16_t* Wgu = (const bf16_t*)(ws + (H_ ? O_WGU2 : O_WGU1) + L_ * SZ_WGU);
                pg8::Gemm g{XB, Wgu, MTOK, NGU, DM}; pg8::StaticOrder S; S.init(MTOK, NGU, G, blk);
                EpiGateUp E{ACT, SSQ};
                pg8::gemm_phase<EpiGateUp, pg8::StaticOrder, true, true>(lds, g, S, E);
            }
            if (l == 0 && half == 0) {
                WSPTRS const int nfull = ((MTOK / 256) * (NGU / 256)) % G;
                pg8::Gemm g{MEMB, (const bf16_t*)(ws + O_WMKV), MMEM, NMKV, DM}; pg8::StaticOrder S; S.init(MMEM, NMKV, G, (blk - nfull + G) % G);
                EpiMemKV E{SSQM, MK, MV, p.in[10]};
                pg8::gemm_phase<EpiMemKV, pg8::StaticOrder, true, true>(lds, g, S, E);
            }
            GRID_SYNC();
            {
                WSPTRS const bf16_t* Wd = (const bf16_t*)(ws + (H_ ? O_WD2 : O_WD1) + L_ * SZ_WD);
                pg8::Gemm g{ACT, Wd, MTOK, DM, DFF}; pg8::StaticOrder S; S.init(MTOK, DM, G, blk);
                EpiResid E{(L_ == 0 && H_ == 0) ? p.in[0] : nullptr, XB, (L_ == 3 && H_ == 1) ? OUT : nullptr, SSQ, 0.5f};
                pg8::gemm_phase<EpiResid, pg8::StaticOrder, true, true>(lds, g, S, E);
            }
            if (l == 3 && half == 1) break;
            GRID_SYNC();
            if (half == 0) {
                if (l < 2) {
                    {   WSPTRS pg8::Gemm g{XB, (const bf16_t*)(ws + O_WINA + L_ * SZ_WINA), MTOK, NINA - 256, DM}; pg8::StaticOrder S; S.init(MTOK, NINA - 256, G, blk);
                        EpiInA E{SSQ, QB, LF, VB, MIX, LBV + L_ * 768, p.in[9] + L_ * 64, 0, (L_ == 0) ? 1 : 0};
                        pg8::gemm_phase<EpiInA, pg8::StaticOrder, true, true>(lds, g, S, E); }
                    GRID_SYNC();
                    { WSPTRS
                    for (int c = blk; c < 48; c += G) hgrn_chain(QB, LF, VB, MIX, MIX, p.in[13] + L_ * 128, c / 6, c % 6, lds);
                    if (G > 48) { if (blk >= 48) {
                        for (int pm = blk - 48; pm < 64; pm += G - 48) {
                            pg8::Gemm g{XB, (const bf16_t*)(ws + O_WINA + L_ * SZ_WINA) + (size_t)(NINA - 256) * DM, MTOK, 256, DM}; OneUnit S1{pm};
                            EpiInA E{SSQ, QB, LF, VB, MIX, LBV + L_ * 768, p.in[9] + L_ * 64, 12};
                            pg8::gemm_phase<EpiInA, OneUnit, true, true>(lds, g, S1, E);
                            asm volatile("s_waitcnt vmcnt(0)" ::: "memory"); __syncthreads();
                            for (int hd = 0; hd < 4; ++hd) mem_attn_item(pm * 4 + hd, L_, MIX, MK, MV, lds);
                        }
                        int tq = threadIdx.x; asm volatile("" : "+v"(tq)); const int wq = __builtin_amdgcn_readfirstlane(tq >> 6);
                        LAS float* scr = (LAS float*)(lds + wq * 16384); const int gw = (blk - 48) * 8 + wq, NGW = (G - 48) * 8; int base = 0;
                        if (L_ == 0) { conv_layer(p, ws, 1, base, gw, NGW, scr, tq & 63); conv_layer(p, ws, 2, base, gw, NGW, scr, tq & 63); }
                        else { conv_layer(p, ws, 3, base, gw, NGW, scr, tq & 63); conv_job(MODE_KV, p.in[17], nullptr, KVSRC, DM, (bf16_t*)(ws + O_WKV), NKV / 32, p.in[16], base, gw, NGW, scr, tq & 63); }
                        __syncthreads(); } }
                    else { for (int pm = blk; pm < 64; pm += G) {
                            pg8::Gemm g{XB, (const bf16_t*)(ws + O_WINA + L_ * SZ_WINA) + (size_t)(NINA - 256) * DM, MTOK, 256, DM}; OneUnit S1{pm};
                            EpiInA E{SSQ, QB, LF, VB, MIX, LBV + L_ * 768, p.in[9] + L_ * 64, 12};
                            pg8::gemm_phase<EpiInA, OneUnit, true, true>(lds, g, S1, E);
                            asm volatile("s_waitcnt vmcnt(0)" ::: "memory"); __syncthreads();
                            for (int hd = 0; hd < 4; ++hd) mem_attn_item(pm * 4 + hd, L_, MIX, MK, MV, lds);
                        }
                        int tq = threadIdx.x; asm volatile("" : "+v"(tq)); const int wq = __builtin_amdgcn_readfirstlane(tq >> 6);
                        LAS float* scr = (LAS float*)(lds + wq * 16384); const int gw = blk * 8 + wq, NGW = G * 8; int base = 0;
                        if (L_ == 0) { conv_layer(p, ws, 1, base, gw, NGW, scr, tq & 63); conv_layer(p, ws, 2, base, gw, NGW, scr, tq & 63); }
                        else { conv_layer(p, ws, 3, base, gw, NGW, scr, tq & 63); conv_job(MODE_KV, p.in[17], nullptr, KVSRC, DM, (bf16_t*)(ws + O_WKV), NKV / 32, p.in[16], base, gw, NGW, scr, tq & 63); }
                        __syncthreads(); } }
                } else {
                    {   WSPTRS pg8::Gemm g{XB, (const bf16_t*)(ws + O_WINB + (L_ - 2) * SZ_WINB), MTOK, NINB, DM}; pg8::StaticOrder S; S.init(MTOK, NINB, G, blk);
                        EpiInB E{SSQ, QB, MIX, p.in[15] + (L_ - 2) * 64, p.in[9] + L_ * 64};
                        pg8::gemm_phase<EpiInB, pg8::StaticOrder, true, true>(lds, g, S, E); }
                    GRID_SYNC();
                    { WSPTRS
                    for (int r = 0;; ++r) {
                        const int idx = r * G + ((r & 1) ? (G - 1 - blk) : blk);
                        if (r * G >= 1024) break;
                        if (idx >= 1024) continue;
                        if (idx < 768) { const int qb = 7 - idx / 96, bh = idx % 96, b = bh / 12, h = bh % 12;
                            bf16_t* op = MIX + ((size_t)b * SEQ + 256 * qb) * 1024 + 64 * h;
                            attn_item(QB + ((size_t)b * SEQ + 256 * qb) * 768 + 64 * h, 768, KSH + (size_t)b * SEQ * 768 + 64 * h, VSH + (size_t)b * SEQ * 768 + 64 * h, 768, 4 * (qb + 1),
                                      DL + (size_t)bh * 2048, 256 * qb, true, op, op, 1024, true, lds);
                        } else mem_attn_item(idx - 768, L_, MIX, MK, MV, lds);
                    } }
                }
                GRID_SYNC();
                {
                    WSPTRS pg8::Gemm g{MIX, (const bf16_t*)(ws + O_WOUT + L_ * SZ_WOUT), MTOK, DM, DM}; pg8::StaticOrder S; S.init(MTOK, DM, G, blk);
                    EpiResid E{nullptr, XB, nullptr, SSQ, 1.0f};
                    pg8::gemm_phase<EpiResid, pg8::StaticOrder, true, true>(lds, g, S, E);
                }
                GRID_SYNC();
            }
        }
        if (l == 1) {
            const int half = 0; WSPTRS pg8::Gemm g{XB, (const bf16_t*)(ws + O_WKV), MTOK, NKV, DM}; pg8::StaticOrder S; S.init(MTOK, NKV, G, blk);
            EpiKV E{SSQ, KSH, VSH, LFX, p.in[19], p.in[18]};
            pg8::gemm_phase<EpiKV, pg8::StaticOrder, true, true>(lds, g, S, E);
            GRID_SYNC();
        }
    }
}

extern "C" void kernel_launch(void* const* d_in, const int* in_sizes, int n_in, void* d_out, int out_size, void* d_ws, size_t ws_size, hipStream_t stream) {
    static int grid = 0;
    if (grid == 0) {
        if (n_in != 25 || out_size != MTOK * DM || ws_size < WS_END) { fprintf(stderr, "kernel_launch: unexpected problem (n_in %d, out %d, ws %zu, need %zu)\n", n_in, out_size, ws_size, (size_t)WS_END); grid = -1; return; }
        int dev = 0, cus = 0, per_cu = 0;
        (void)hipGetDevice(&dev); (void)hipDeviceGetAttribute(&cus, hipDeviceAttributeMultiprocessorCount, dev);
        (void)hipFuncSetAttribute((const void*)fwd_kernel, hipFuncAttributeMaxDynamicSharedMemorySize, LDS_BYTES);
        if (hipOccupancyMaxActiveBlocksPerMultiprocessor(&per_cu, (const void*)fwd_kernel, NTHREADS, LDS_BYTES) != hipSuccess || per_cu < 1) per_cu = 1;
        (void)hipGetLastError();
        grid = cus * per_cu; if (grid < 1) grid = 256;
    }
    if (grid < 0) return;
    Params p{};
    for (int i = 0; i < 25; ++i) p.in[i] = (const float*)d_in[i];
    p.out = (float*)d_out; p.ws = (unsigned char*)d_ws;
    if (hipMemsetAsync((unsigned char*)d_ws + O_BAR, 0, XCD_BAR_WORDS_C * 4, stream) != hipSuccess) { fprintf(stderr, "kernel_launch: memset of the barrier words failed\n"); return; }
    void* args[] = {&p};
    hipError_t e = hipLaunchCooperativeKernel((const void*)fwd_kernel, dim3(grid), dim3(NTHREADS), args, LDS_BYTES, stream);
    if (e != hipSuccess) fprintf(stderr, "cooperative launch failed: %s (grid %d)\n", hipGetErrorString(e), grid);
}
```
